# Optimizing an MI355X kernel written in HIP

```python
import jax, jax.numpy as jnp
from jax import lax
import numpy as np

D_MODEL = 2048
BATCH = 4
SEQ = 4096
DEPTH = 1

HEAD_DIM = 128
ATTN_HEADS = 8
MLSTM_HEADS = 8
ATTN_WIDTH = ATTN_HEADS * HEAD_DIM
MLSTM_WIDTH = MLSTM_HEADS * HEAD_DIM
MIX_WIDTH = ATTN_WIDTH + MLSTM_WIDTH
ATTN_PATTERNS = ((128, 1), (512, 4), (2048, 16))
ATTN_BLOCK = 128
MLSTM_CHUNK = 128
CONV_WIDTH = 4
FFN_HIDDEN = ((8 * D_MODEL + 3 * 256 - 1) // (3 * 256)) * 256
IN_WIDTH = 3 * ATTN_WIDTH + 4 * MLSTM_WIDTH + 2 * MLSTM_HEADS
EPS = 1e-6
MASK_VALUE = -1e30
M_INIT = -1e30

kernel_name = "hybrid_dilated_attn_mlstm_block"


def rmsnorm(x, g):
    x32 = x.astype(jnp.float32)
    y = x32 * lax.rsqrt(jnp.mean(x32 * x32, axis=-1, keepdims=True) + EPS)
    return (y * g.astype(jnp.float32)).astype(x.dtype)


def causal_depthwise_conv(u, w, b):
    c = u.shape[-1]
    y = lax.conv_general_dilated(u, w[:, None, :].astype(u.dtype), window_strides=(1,),
                                 padding=[(CONV_WIDTH - 1, 0)],
                                 dimension_numbers=("NWC", "WIO", "NWC"),
                                 feature_group_count=c)
    return y + b.astype(u.dtype)


def strided_window_attention(q, k, v, span, dil):
    assert span <= ATTN_BLOCK
    B, S, H, Dh = q.shape
    n = S // dil
    nb = -(-n // ATTN_BLOCK)
    n_pad = nb * ATTN_BLOCK

    def to_blocks(t):
        t = t.reshape(B, n, dil, H, Dh)
        t = jnp.pad(t, ((0, 0), (0, n_pad - n), (0, 0), (0, 0), (0, 0)))
        return t.reshape(B, nb, ATTN_BLOCK, dil, H, Dh)

    def with_prev(t):
        prev = jnp.pad(t, ((0, 0), (1, 0), (0, 0), (0, 0), (0, 0), (0, 0)))[:, :-1]
        return jnp.concatenate([prev, t], axis=2)

    qb = to_blocks(q)
    kw = with_prev(to_blocks(k))
    vw = with_prev(to_blocks(v))
    scores = jnp.einsum("bnqrhd,bnkrhd->bnrhqk", qb, kw).astype(jnp.float32)
    q_idx = jnp.arange(ATTN_BLOCK)[:, None]
    k_idx = jnp.arange(2 * ATTN_BLOCK)[None, :] - ATTN_BLOCK
    dist = q_idx - k_idx
    blk = jnp.arange(nb)[:, None, None]
    valid = (dist >= 0) & (dist <= span) & (blk * ATTN_BLOCK + k_idx >= 0)
    scores = jnp.where(valid[None, :, None, None], scores, MASK_VALUE)
    m = jnp.max(scores, axis=-1, keepdims=True)
    p = jnp.exp(scores - m)
    s = jnp.sum(p, axis=-1, keepdims=True)
    o = jnp.einsum("bnrhqk,bnkrhd->bnqrhd", p / s, vw.astype(jnp.float32))
    lse = (m + jnp.log(s))[..., 0]
    o = o.reshape(B, n_pad, dil, H, Dh)[:, :n].reshape(B, S, H, Dh)
    lse = lse.transpose(0, 1, 4, 2, 3).reshape(B, n_pad, dil, H)[:, :n].reshape(B, S, H)
    return o, lse


def dilated_window_attention(q, k, v):
    outs, lses = [], []
    for window, dil in ATTN_PATTERNS:
        o, lse = strided_window_attention(q, k, v, window // dil, dil)
        outs.append(o)
        lses.append(lse)
    alpha = jax.nn.softmax(jnp.stack(lses, axis=0), axis=0)
    out = jnp.sum(alpha[..., None] * jnp.stack(outs, axis=0), axis=0)
    return out.astype(q.dtype)


def mlstm_chunkwise(q, k, v, i_pre, f_pre):
    B, S, H, Dh = q.shape
    L = MLSTM_CHUNK
    nc = S // L

    def chunks(t):
        return t.astype(jnp.float32).transpose(0, 2, 1, 3).reshape(B, H, nc, L, Dh)

    def gchunks(t):
        return t.astype(jnp.float32).transpose(0, 2, 1).reshape(B, H, nc, L)

    qc, kc, vc = chunks(q), chunks(k) * (Dh ** -0.5), chunks(v)
    ic = gchunks(i_pre)
    b = jnp.cumsum(jax.nn.log_sigmoid(gchunks(f_pre)), axis=-1)

    b_last = b[..., -1]
    a = b_last[..., None] - b + ic
    m_chunk = jnp.max(a, axis=-1)
    wa = jnp.exp(a - m_chunk[..., None])
    kv_chunk = jnp.einsum("bhcl,bhcld,bhcle->bhcde", wa, kc, vc)
    n_chunk = jnp.einsum("bhcl,bhcld->bhcd", wa, kc)

    def step(carry, xs):
        C, nvec, m = carry
        bl, mc, kvc, nch = xs
        m_new = jnp.maximum(bl + m, mc)
        decay = jnp.exp(bl + m - m_new)
        scale = jnp.exp(mc - m_new)
        C_new = decay[..., None, None] * C + scale[..., None, None] * kvc
        n_new = decay[..., None] * nvec + scale[..., None] * nch
        return (C_new, n_new, m_new), (C, nvec, m)

    init = (jnp.zeros((B, H, Dh, Dh), jnp.float32), jnp.zeros((B, H, Dh), jnp.float32),
            jnp.full((B, H), M_INIT, jnp.float32))
    xs = (jnp.moveaxis(b_last, 2, 0), jnp.moveaxis(m_chunk, 2, 0),
          jnp.moveaxis(kv_chunk, 2, 0), jnp.moveaxis(n_chunk, 2, 0))
    _, (C_prev, n_prev, m_prev) = lax.scan(step, init, xs)
    C_prev = jnp.moveaxis(C_prev, 0, 2)
    n_prev = jnp.moveaxis(n_prev, 0, 2)
    m_prev = jnp.moveaxis(m_prev, 0, 2)

    causal = jnp.tril(jnp.ones((L, L), dtype=bool))
    log_d = jnp.where(causal, b[..., :, None] - b[..., None, :] + ic[..., None, :], MASK_VALUE)
    inter = b + m_prev[..., None]
    m_t = jnp.maximum(inter, jnp.max(log_d, axis=-1))
    w = jnp.exp(log_d - m_t[..., None]) * jnp.einsum("bhcld,bhcsd->bhcls", qc, kc)
    g = jnp.exp(inter - m_t)
    num = g[..., None] * jnp.einsum("bhcld,bhcde->bhcle", qc, C_prev) + jnp.einsum("bhcls,bhcse->bhcle", w, vc)
    den = g * jnp.einsum("bhcld,bhcd->bhcl", qc, n_prev) + jnp.sum(w, axis=-1)
    h = num / jnp.maximum(jnp.abs(den), jnp.exp(-m_t))[..., None]
    return h.reshape(B, H, S, Dh).transpose(0, 2, 1, 3).astype(q.dtype)


def setup_inputs(seed: int = 0) -> dict:
    key = jax.random.key(seed)
    ks = jax.random.split(key, 16)

    def normal(k, shape, scale):
        return jax.random.normal(k, shape, jnp.float32) * scale

    x = normal(ks[0], (BATCH, SEQ, D_MODEL), 1.0)
    norm_mix_g = 1.0 + normal(ks[1], (DEPTH, D_MODEL), 0.02)
    w_in = normal(ks[2], (DEPTH, D_MODEL, IN_WIDTH), D_MODEL ** -0.5)
    conv_w = normal(ks[3], (DEPTH, CONV_WIDTH, 2 * MLSTM_WIDTH), CONV_WIDTH ** -0.5)
    conv_b = normal(ks[4], (DEPTH, 2 * MLSTM_WIDTH), 0.02)
    i_bias = normal(ks[5], (DEPTH, MLSTM_HEADS), 0.1)
    f_bias = jnp.linspace(3.0, 6.0, MLSTM_HEADS, dtype=jnp.float32)[None] + normal(ks[6], (DEPTH, MLSTM_HEADS), 0.1)
    gate_b = jnp.concatenate([i_bias, f_bias], axis=-1)
    q_norm_g = 1.0 + normal(ks[7], (DEPTH, HEAD_DIM), 0.02)
    k_norm_g = 1.0 + normal(ks[8], (DEPTH, HEAD_DIM), 0.02)
    mlstm_norm_g = 1.0 + normal(ks[9], (DEPTH, MLSTM_HEADS, HEAD_DIM), 0.02)
    w_out = normal(ks[10], (DEPTH, MIX_WIDTH, D_MODEL), MIX_WIDTH ** -0.5)
    norm_ffn_g = 1.0 + normal(ks[11], (DEPTH, D_MODEL), 0.02)
    w_gate = normal(ks[12], (DEPTH, D_MODEL, FFN_HIDDEN), D_MODEL ** -0.5)
    w_up = normal(ks[13], (DEPTH, D_MODEL, FFN_HIDDEN), D_MODEL ** -0.5)
    w_down = normal(ks[14], (DEPTH, FFN_HIDDEN, D_MODEL), FFN_HIDDEN ** -0.5)
    return {"x": x, "norm_mix_g": norm_mix_g, "w_in": w_in, "conv_w": conv_w, "conv_b": conv_b,
            "gate_b": gate_b, "q_norm_g": q_norm_g, "k_norm_g": k_norm_g, "mlstm_norm_g": mlstm_norm_g,
            "w_out": w_out, "norm_ffn_g": norm_ffn_g, "w_gate": w_gate, "w_up": w_up, "w_down": w_down}


def reference(x, norm_mix_g, w_in, conv_w, conv_b, gate_b, q_norm_g, k_norm_g, mlstm_norm_g,
              w_out, norm_ffn_g, w_gate, w_up, w_down):
    B, S, _ = x.shape
    offsets = [ATTN_WIDTH * i for i in (1, 2, 3)] + [3 * ATTN_WIDTH + MLSTM_WIDTH * i for i in (1, 2, 3, 4)]

    def heads(t, n_heads):
        return t.reshape(B, S, n_heads, HEAD_DIM)

    for layer in range(DEPTH):
        h = rmsnorm(x, norm_mix_g[layer])
        proj = h @ w_in[layer]
        aq, ak, av, mq, mk, mv, mo, gates = jnp.split(proj, offsets, axis=-1)

        aq = rmsnorm(heads(aq, ATTN_HEADS), q_norm_g[layer]) * (HEAD_DIM ** -0.5)
        ak = rmsnorm(heads(ak, ATTN_HEADS), k_norm_g[layer])
        attn_out = dilated_window_attention(aq, ak, heads(av, ATTN_HEADS)).reshape(B, S, ATTN_WIDTH)

        mqk = jax.nn.silu(causal_depthwise_conv(jnp.concatenate([mq, mk], axis=-1), conv_w[layer], conv_b[layer]))
        mq, mk = jnp.split(mqk, 2, axis=-1)
        gates = gates + gate_b[layer]
        cell = mlstm_chunkwise(heads(mq, MLSTM_HEADS), heads(mk, MLSTM_HEADS), heads(mv, MLSTM_HEADS),
                               gates[..., :MLSTM_HEADS], gates[..., MLSTM_HEADS:])
        mlstm_out = jax.nn.sigmoid(mo) * rmsnorm(cell, mlstm_norm_g[layer]).reshape(B, S, MLSTM_WIDTH)

        x = x + jnp.concatenate([attn_out, mlstm_out], axis=-1) @ w_out[layer]

        h = rmsnorm(x, norm_ffn_g[layer])
        x = x + (jax.nn.silu(h @ w_gate[layer]) * (h @ w_up[layer])) @ w_down[layer]
    return x
```

```cpp
#include <hip/hip_runtime.h>
#include <cstdio>
#include <cstdint>
namespace pg8 {
#define PG8_LAS __attribute__((address_space(3)))
typedef unsigned short bf16_t;
typedef short bf16x8 __attribute__((ext_vector_type(8)));
typedef float f32x4 __attribute__((ext_vector_type(4)));
typedef unsigned u32x4 __attribute__((ext_vector_type(4)));
constexpr int BM = 256, BK = 64, HALF = 128, HTB = HALF * BK * 2  , STAGE_BYTES = 8 * HTB, NXCD = 8, WGM = 8;

__host__ __device__ __forceinline__ int lds_byte(int r, int c) { const int st = (r >> 4) * 2 + (c >> 5), rr = r & 15, cc = c & 31, ob = rr * 64 + cc * 2; return st * 1024 + (ob ^ (((ob >> 9) & 1) << 5)); }
__host__ __device__ __forceinline__ void stage_rc(int b, int& R, int& C) { const int st = b / 1024, sb = b % 1024, swz = sb ^ (((sb >> 9) & 1) << 5); R = (st >> 1) * 16 + swz / 64; C = (st & 1) * 32 + (swz % 64) / 2; }
__host__ __device__ __forceinline__ int perm32(int rho) { const int n = rho >> 4, i = rho & 15; return 8 * (i >> 2) + 4 * n + (i & 3); }

struct Unit { int pm, pn; };
struct Gemm { const bf16_t* A; const bf16_t* Bt; int M, N, K; };

struct StaticOrder {
    int nM, nN, nwg, G, c;
    __host__ __device__ void init(int M, int N, int G_, int c_) { nM = M / BM; nN = N / BM; nwg = nM * nN; G = G_; c = c_; }
    __host__ __device__ bool next(int i, Unit& u) const {
        const long L = (long)i * G + c; if (L >= nwg) return false;
        int wgid = (int)L; { const int q = nwg / NXCD, r = nwg % NXCD, xcd = wgid % NXCD, off = wgid / NXCD; wgid = (xcd < r ? xcd * (q + 1) : r * (q + 1) + (xcd - r) * q) + off; }
        const int nig = WGM * nN, gid = wgid / nig, fm = gid * WGM, gsz = (nM - fm) < WGM ? (nM - fm) : WGM;
        u.pm = fm + ((wgid % nig) % gsz); u.pn = (wgid % nig) / gsz; return true;
    }
    __device__ __forceinline__ void a_ready(const Unit&) const {}
    __device__ __forceinline__ void done(const Unit&) const {}
};
typedef float f32x2 __attribute__((ext_vector_type(2)));
typedef __bf16 bf16x2_t __attribute__((ext_vector_type(2)));
typedef unsigned u32x2 __attribute__((ext_vector_type(2)));
__device__ __forceinline__ unsigned cvt_pk_bf16(float lo, float hi) { f32x2 v = {lo, hi}; bf16x2_t b = __builtin_convertvector(v, bf16x2_t); return __builtin_bit_cast(unsigned, b); }

struct EpiProj {
    static constexpr bool PERM = true, AFTER_DRAIN = false;
    bf16_t* O; int ldc  ; const float* qg; const float* kg; PG8_LAS float* sm; float eps, qscale;
    __device__ __forceinline__ void operator()(const f32x4 (&acc)[2][2][4][2], const Unit& u, int wr, int wc, int fr, int fq) const {
        const int row0 = u.pm * BM + wr * 64 + fr, col0 = wc * 32 + 8 * fq;
        bf16_t* const slab = O + (size_t)(2 * u.pn) * ldc * HALF;
        if (u.pn < 8) {
            const float* gsrc = (u.pn < 4 ? qg : kg) + wc * 32 + 8 * fq; const float extra = u.pn < 4 ? qscale : 1.0f;
            const f32x4 ga = *(const f32x4*)gsrc, gb = *(const f32x4*)(gsrc + 4);
#pragma unroll
            for (int ai = 0; ai < 2; ++ai)
#pragma unroll
                for (int m = 0; m < 4; ++m)
#pragma unroll
                    for (int bj = 0; bj < 2; ++bj) { const f32x4 v0 = acc[ai][bj][m][0], v1 = acc[ai][bj][m][1];
                        float s = ((v0[0] * v0[0] + v0[1] * v0[1]) + (v0[2] * v0[2] + v0[3] * v0[3])) + ((v1[0] * v1[0] + v1[1] * v1[1]) + (v1[2] * v1[2] + v1[3] * v1[3]));
                        s += __shfl_xor(s, 16); s += __shfl_xor(s, 32);
                        if (fq == 0) sm[((ai * HALF + wr * 64 + m * 16 + fr) * 2 + bj) * 4 + wc] = s; }
            asm volatile("s_waitcnt lgkmcnt(0)" ::: "memory"); __builtin_amdgcn_s_barrier(); asm volatile("" ::: "memory");
#pragma unroll
            for (int ai = 0; ai < 2; ++ai)
#pragma unroll
                for (int m = 0; m < 4; ++m) { bf16_t* rowp = slab + (size_t)(row0 + ai * HALF + m * 16) * HALF + col0;
#pragma unroll
                    for (int bj = 0; bj < 2; ++bj) { const f32x4 pv = *(const PG8_LAS f32x4*)(sm + ((ai * HALF + wr * 64 + m * 16 + fr) * 2 + bj) * 4);
                        const float rs = __builtin_amdgcn_rsqf(((pv[0] + pv[1]) + (pv[2] + pv[3])) * (1.0f / 128.0f) + eps) * extra;
                        const f32x4 v0 = acc[ai][bj][m][0] * ga * rs, v1 = acc[ai][bj][m][1] * gb * rs;
                        u32x4 w; w.x = cvt_pk_bf16(v0[0], v0[1]); w.y = cvt_pk_bf16(v0[2], v0[3]); w.z = cvt_pk_bf16(v1[0], v1[1]); w.w = cvt_pk_bf16(v1[2], v1[3]);
                        *(u32x4*)(rowp + (size_t)bj * ldc * HALF) = w; } }
            asm volatile("s_waitcnt lgkmcnt(0)" ::: "memory"); __builtin_amdgcn_s_barrier(); asm volatile("" ::: "memory");
            return;
        }
#pragma unroll
        for (int ai = 0; ai < 2; ++ai)
#pragma unroll
            for (int m = 0; m < 4; ++m) { bf16_t* rowp = slab + (size_t)(row0 + ai * HALF + m * 16) * HALF + col0;
#pragma unroll
                for (int bj = 0; bj < 2; ++bj) { const f32x4 v0 = acc[ai][bj][m][0], v1 = acc[ai][bj][m][1];
                    u32x4 w; w.x = cvt_pk_bf16(v0[0], v0[1]); w.y = cvt_pk_bf16(v0[2], v0[3]); w.z = cvt_pk_bf16(v1[0], v1[1]); w.w = cvt_pk_bf16(v1[2], v1[3]);
                    *(u32x4*)(rowp + (size_t)bj * ldc * HALF) = w; } }
    }
};
struct EpiRes1 {
    static constexpr bool PERM = false, AFTER_DRAIN = false;
    const float* X; float* X1; bf16_t* X1B; float* rowss; int ldc;
    __device__ __forceinline__ void operator()(const f32x4 (&acc)[2][2][4][2], const Unit& u, int wr, int wc, int fr, int fq) const {
        const int row0 = u.pm * BM + wr * 64 + fr, col0 = u.pn * BM + wc * 32 + 4 * fq;
#pragma unroll
        for (int ai = 0; ai < 2; ++ai)
#pragma unroll
            for (int m = 0; m < 4; ++m) { const int r = row0 + ai * HALF + m * 16; const size_t off = (size_t)r * ldc + col0; float ss = 0.f;
#pragma unroll
                for (int bj = 0; bj < 2; ++bj)
#pragma unroll
                    for (int n = 0; n < 2; ++n) { const size_t c = off + bj * HALF + n * 16; const f32x4 xv = *(const f32x4*)(X + c); const f32x4 v = xv + acc[ai][bj][m][n];
                        *(f32x4*)(X1 + c) = v; ss += (v[0] * v[0] + v[1] * v[1]) + (v[2] * v[2] + v[3] * v[3]);
                        u32x2 w; w.x = cvt_pk_bf16(v[0], v[1]); w.y = cvt_pk_bf16(v[2], v[3]); *(u32x2*)(X1B + c) = w; }
                ss += __shfl_xor(ss, 16); ss += __shfl_xor(ss, 32);
                if (fq == 0) atomicAdd(rowss + r, ss);
                if (m == 3) asm volatile("" ::: "memory"); }
    }
};
struct EpiSwi {
    static constexpr bool PERM = true, AFTER_DRAIN = false;
    bf16_t* H; int ldc; const float* rowss; float eps;
    __device__ __forceinline__ void operator()(const f32x4 (&acc)[2][2][4][2], const Unit& u, int wr, int wc, int fr, int fq) const {
        const int row0 = u.pm * BM + wr * 64 + fr, col0 = u.pn * HALF + wc * 32 + 8 * fq;
        float rsv[2][4];
#pragma unroll
        for (int ai = 0; ai < 2; ++ai)
#pragma unroll
            for (int m = 0; m < 4; ++m) rsv[ai][m] = rowss[row0 + ai * HALF + m * 16];
#pragma unroll
        for (int ai = 0; ai < 2; ++ai)
#pragma unroll
            for (int m = 0; m < 4; ++m) { const int r = row0 + ai * HALF + m * 16; const float s = __builtin_amdgcn_rsqf(rsv[ai][m] * (1.0f / 2048.0f) + eps);
                float hv[8];
#pragma unroll
                for (int n = 0; n < 2; ++n)
#pragma unroll
                    for (int j = 0; j < 4; ++j) { const float g = acc[ai][0][m][n][j] * s, up = acc[ai][1][m][n][j] * s; hv[n * 4 + j] = g * __builtin_amdgcn_rcpf(1.0f + __expf(-g)) * up; }
                u32x4 w; w.x = cvt_pk_bf16(hv[0], hv[1]); w.y = cvt_pk_bf16(hv[2], hv[3]); w.z = cvt_pk_bf16(hv[4], hv[5]); w.w = cvt_pk_bf16(hv[6], hv[7]);
                *(u32x4*)(H + (size_t)r * ldc + col0) = w; }
    }
};
struct EpiNone {
    static constexpr bool PERM = true, AFTER_DRAIN = false;
    __device__ __forceinline__ void operator()(const f32x4 (&acc)[2][2][4][2], const Unit& u, int wr, int wc, int fr, int fq) const {
#pragma unroll
        for (int ai = 0; ai < 2; ++ai)
#pragma unroll
            for (int m = 0; m < 4; ++m)
#pragma unroll
                for (int bj = 0; bj < 2; ++bj) asm volatile("" :: "v"(acc[ai][bj][m][0]), "v"(acc[ai][bj][m][1]));
    }
};
struct EpiRes2 {
    static constexpr bool PERM = false, AFTER_DRAIN = false;
    float* OUT; int ldc;
    __device__ __forceinline__ void operator()(const f32x4 (&acc)[2][2][4][2], const Unit& u, int wr, int wc, int fr, int fq) const {
        const int row0 = u.pm * BM + wr * 64 + fr, col0 = u.pn * BM + wc * 32 + 4 * fq;
#pragma unroll
        for (int ai = 0; ai < 2; ++ai)
#pragma unroll
            for (int m = 0; m < 4; ++m) { float* rowp = OUT + (size_t)(row0 + ai * HALF + m * 16) * ldc + col0;
#pragma unroll
                for (int bj = 0; bj < 2; ++bj)
#pragma unroll
                    for (int n = 0; n < 2; ++n) { f32x4* p = (f32x4*)(rowp + bj * HALF + n * 16); *p = *p + acc[ai][bj][m][n]; }
                if (m == 3) asm volatile("" ::: "memory"); }
    }
};

template <class Epi, class Sched, bool ALIGN_EPI = false, bool SP2 = false>
__device__ __forceinline__ void gemm_phase(PG8_LAS unsigned char* lds, const Gemm g, const Sched& S, const Epi& E) {
    const int tid = threadIdx.x, wid = __builtin_amdgcn_readfirstlane(tid >> 6), lane = tid & 63, wr = wid >> 2, wc = wid & 3, fr = lane & 15, fq = lane >> 4;
    const int K = g.K, nt = K / BK;
    unsigned voffA[2], voffB[2];
#pragma unroll
    for (int i = 0; i < 2; ++i) { int R, C; stage_rc(tid * 16 + i * 8192, R, C); const int Rb = Epi::PERM ? ((R & ~31) + perm32(R & 31)) : R;
        voffA[i] = (unsigned)(R * K + C) * 2u; voffB[i] = (unsigned)(Rb * K + C) * 2u; }
    const size_t kstep = (size_t)(BK * 2);
    const size_t hstep = (size_t)HALF * K * 2;
    const size_t tstep = 2 * hstep;
    const unsigned ldsw = (unsigned)wid * 1024u;
    const int aoff = lds_byte(wr * 64 + fr, fq * 8), boff = lds_byte(wc * 32 + fr, fq * 8);
#define PG8_SA(b, h) (((b) * 2 + (h)) * HTB)
#define PG8_SB(b, h) ((4 + (b) * 2 + (h)) * HTB)
#define PG8_STAGE(bufoff, gbase, voff) do { _Pragma("unroll") for (int _i = 0; _i < 2; ++_i) \
        __builtin_amdgcn_global_load_lds((const unsigned*)((const char*)(gbase) + (voff)[_i]), (PG8_LAS unsigned*)(lds + (bufoff) + ldsw + _i * 8192), 16, 0, 0); } while (0)
#define PG8_LDA(dst, b, h) do { _Pragma("unroll") for (int m = 0; m < 4; ++m) _Pragma("unroll") for (int k = 0; k < 2; ++k) dst[m][k] = *(const PG8_LAS bf16x8*)(lds + PG8_SA(b, h) + aoff + m * 2048 + k * 1024); } while (0)
#define PG8_LDB(dst, b, h) do { _Pragma("unroll") for (int n = 0; n < 2; ++n) _Pragma("unroll") for (int k = 0; k < 2; ++k) dst[n][k] = *(const PG8_LAS bf16x8*)(lds + PG8_SB(b, h) + boff + n * 2048 + k * 1024); } while (0)
#define PG8_MMA(ai, bj, At, Bt) do { __builtin_amdgcn_s_setprio(1); _Pragma("unroll") for (int m = 0; m < 4; ++m) _Pragma("unroll") for (int n = 0; n < 2; ++n) _Pragma("unroll") for (int k = 0; k < 2; ++k) \
        acc[ai][bj][m][n] = __builtin_amdgcn_mfma_f32_16x16x32_bf16(Bt[n][k], At[m][k], acc[ai][bj][m][n], 0, 0, 0); __builtin_amdgcn_s_setprio(0); } while (0)
#define PG8_WAIT_V(n) asm volatile("s_waitcnt vmcnt(" #n ")" ::: "memory")
#define PG8_WAIT_L(n) asm volatile("s_waitcnt lgkmcnt(" #n ")" ::: "memory")
#define PG8_BAR __builtin_amdgcn_s_barrier()
#define PG8_SCHED __builtin_amdgcn_sched_barrier(0)
    Unit cur, nxt; int ui = 0;
    if (!S.next(0, cur)) return;
    f32x4 acc[2][2][4][2];
#pragma unroll
    for (int a = 0; a < 2; ++a)
#pragma unroll
        for (int b = 0; b < 2; ++b)
#pragma unroll
            for (int m = 0; m < 4; ++m)
#pragma unroll
                for (int n = 0; n < 2; ++n) acc[a][b][m][n] = (f32x4){0.f, 0.f, 0.f, 0.f};
    bf16x8 At[4][2], B0[2][2], B1[2][2];
    const char* cA = (const char*)g.A + (size_t)cur.pm * tstep; const char* cB = (const char*)g.Bt + (size_t)cur.pn * tstep;
    S.a_ready(cur);
    if constexpr (SP2) {
        PG8_STAGE(PG8_SB(0, 0), cB, voffB); PG8_STAGE(PG8_SB(0, 1), cB + hstep, voffB); PG8_STAGE(PG8_SA(0, 0), cA, voffA); PG8_STAGE(PG8_SA(0, 1), cA + hstep, voffA);
        if (wr == 1) PG8_BAR;
        PG8_WAIT_V(2); PG8_BAR;
        PG8_STAGE(PG8_SB(1, 0), cB + kstep, voffB); PG8_STAGE(PG8_SA(1, 0), cA + kstep, voffA); PG8_STAGE(PG8_SB(1, 1), cB + hstep + kstep, voffB);
        PG8_WAIT_V(6); PG8_BAR;
    } else {
        PG8_STAGE(PG8_SB(0, 0), cB, voffB); PG8_STAGE(PG8_SA(0, 0), cA, voffA); PG8_STAGE(PG8_SB(0, 1), cB + hstep, voffB); PG8_STAGE(PG8_SA(0, 1), cA + hstep, voffA);
        if (wr == 1) PG8_BAR;
        PG8_WAIT_V(4); PG8_BAR;
        PG8_STAGE(PG8_SB(1, 0), cB + kstep, voffB); PG8_STAGE(PG8_SA(1, 0), cA + kstep, voffA); PG8_STAGE(PG8_SB(1, 1), cB + hstep + kstep, voffB);
        PG8_WAIT_V(6); PG8_BAR;
    }
    for (;;) {
        const bool has_next = S.next(ui + 1, nxt);
        const char* nA = has_next ? (const char*)g.A + (size_t)nxt.pm * tstep : cA; const char* nB = has_next ? (const char*)g.Bt + (size_t)nxt.pn * tstep : cB;
        for (int t = 0; t < nt; t += 2) {
            const bool last = (t == nt - 2);
            const char* a1 = cA + (size_t)(t + 1) * kstep;
            const char* a2 = last ? nA : cA + (size_t)(t + 2) * kstep; const char* b2 = last ? nB : cB + (size_t)(t + 2) * kstep;
            const char* a3 = a2 + kstep; const char* b3 = b2 + kstep;
            if (last && has_next) S.a_ready(nxt);
            if constexpr (SP2) {
            PG8_LDB(B0, 0, 0); PG8_LDB(B1, 0, 1); PG8_SCHED; PG8_LDA(At, 0, 0); PG8_STAGE(PG8_SA(1, 1), a1 + hstep, voffA);
            PG8_WAIT_V(8); PG8_WAIT_L(0); PG8_BAR; PG8_MMA(0, 0, At, B0); PG8_MMA(0, 1, At, B1); PG8_BAR; PG8_SCHED;
            PG8_LDA(At, 0, 1); PG8_STAGE(PG8_SB(0, 0), b2, voffB); PG8_STAGE(PG8_SB(0, 1), b2 + hstep, voffB); PG8_STAGE(PG8_SA(0, 0), a2, voffA);
            PG8_WAIT_V(8); PG8_WAIT_L(0); PG8_BAR; PG8_MMA(1, 0, At, B0); PG8_MMA(1, 1, At, B1); PG8_BAR; PG8_SCHED;
            PG8_LDB(B0, 1, 0); PG8_LDB(B1, 1, 1); PG8_SCHED; PG8_LDA(At, 1, 0); PG8_STAGE(PG8_SA(0, 1), a2 + hstep, voffA);
            PG8_WAIT_V(8); PG8_WAIT_L(0); PG8_BAR; PG8_MMA(0, 0, At, B0); PG8_MMA(0, 1, At, B1); PG8_BAR; PG8_SCHED;
            PG8_LDA(At, 1, 1); PG8_STAGE(PG8_SB(1, 0), b3, voffB); PG8_STAGE(PG8_SB(1, 1), b3 + hstep, voffB); PG8_STAGE(PG8_SA(1, 0), a3, voffA);
            PG8_WAIT_V(8); PG8_WAIT_L(0); PG8_BAR; PG8_MMA(1, 0, At, B0); PG8_MMA(1, 1, At, B1); PG8_BAR; PG8_SCHED;
            } else {
            PG8_LDB(B0, 0, 0); PG8_SCHED; PG8_LDA(At, 0, 0); PG8_STAGE(PG8_SA(1, 1), a1 + hstep, voffA);
            PG8_WAIT_L(8); PG8_BAR; PG8_WAIT_L(0); PG8_MMA(0, 0, At, B0); PG8_BAR; PG8_SCHED;
            PG8_LDB(B1, 0, 1); PG8_STAGE(PG8_SB(0, 0), b2, voffB);
            PG8_BAR; PG8_WAIT_L(0); PG8_MMA(0, 1, At, B1); PG8_BAR;
            PG8_LDA(At, 0, 1); PG8_STAGE(PG8_SA(0, 0), a2, voffA);
            PG8_BAR; PG8_WAIT_L(0); PG8_MMA(1, 0, At, B0); PG8_BAR; PG8_SCHED;
            PG8_STAGE(PG8_SB(0, 1), b2 + hstep, voffB);
            PG8_WAIT_V(6); PG8_BAR; PG8_MMA(1, 1, At, B1); PG8_BAR;
            PG8_LDB(B0, 1, 0); PG8_SCHED; PG8_LDA(At, 1, 0); PG8_STAGE(PG8_SA(0, 1), a2 + hstep, voffA);
            PG8_WAIT_L(8); PG8_BAR; PG8_WAIT_L(0); PG8_MMA(0, 0, At, B0); PG8_BAR; PG8_SCHED;
            PG8_LDB(B1, 1, 1); PG8_STAGE(PG8_SB(1, 0), b3, voffB);
            PG8_BAR; PG8_WAIT_L(0); PG8_MMA(0, 1, At, B1); PG8_BAR;
            PG8_LDA(At, 1, 1); PG8_STAGE(PG8_SA(1, 0), a3, voffA);
            PG8_BAR; PG8_WAIT_L(0); PG8_MMA(1, 0, At, B0); PG8_BAR; PG8_SCHED;
            PG8_STAGE(PG8_SB(1, 1), b3 + hstep, voffB);
            PG8_WAIT_V(6); PG8_BAR; PG8_MMA(1, 1, At, B1); PG8_BAR;
            }
        }
        if constexpr (ALIGN_EPI) { if (wr == 0) PG8_BAR; }
        if constexpr (!Epi::AFTER_DRAIN) { E(acc, cur, wr, wc, fr, fq); S.done(cur); }
        if (!has_next) break;
#pragma unroll
        for (int a = 0; a < 2; ++a)
#pragma unroll
            for (int b = 0; b < 2; ++b)
#pragma unroll
                for (int m = 0; m < 4; ++m)
#pragma unroll
                    for (int n = 0; n < 2; ++n) acc[a][b][m][n] = (f32x4){0.f, 0.f, 0.f, 0.f};
        cur = nxt; cA = nA; cB = nB; ++ui;
        if constexpr (ALIGN_EPI) { if (wr == 1) PG8_BAR; }
    }
    PG8_WAIT_V(0);
    if constexpr (!ALIGN_EPI) { if (wr == 0) PG8_BAR; }
    PG8_BAR;
    if constexpr (Epi::AFTER_DRAIN) { E.fused(acc, cur, wr, wc, fr, fq, lds, wid, lane); S.done(cur); }
#undef PG8_SA
#undef PG8_SB
#undef PG8_STAGE
#undef PG8_LDA
#undef PG8_LDB
#undef PG8_MMA
#undef PG8_WAIT_V
#undef PG8_WAIT_L
#undef PG8_BAR
#undef PG8_SCHED
}
}

constexpr int NWAVES = 8;
#ifndef PHASE_LIST
#define PHASE_LIST {0, 8}
#endif
constexpr int N_PHASES = 8;

constexpr int BATCH = 4, SEQ = 4096, DM = 2048, HD = 128, NH = 8, AW = 1024, FF = 5632;
constexpr int T = BATCH * SEQ;
constexpr int INW = 7184, PJ = 7168;
constexpr int S_AQ = 0, S_AK = 1, S_AV = 2, S_MQ = 3, S_MK = 4, S_MV = 5, S_MO = 6;
constexpr int NCH = SEQ / 128;
constexpr float EPS = 1e-6f;
constexpr float LOG2E = 1.4426950408889634f, LN2 = 0.6931471805599453f;
constexpr float RSQRT_HD = 0.08838834764831845f;

constexpr size_t MiB = 1u << 20;
constexpr size_t WS_CTL = 0, CTL_ZERO_BYTES = 1 * MiB;
constexpr size_t WS_WIN = 1 * MiB;
constexpr size_t WS_WOUT = 29 * MiB;
constexpr size_t WS_WGU = 37 * MiB;
constexpr size_t WS_WDN = 81 * MiB;
constexpr size_t WS_HB = 104 * MiB;
constexpr size_t WS_PROJ = 168 * MiB;
constexpr size_t WS_MIX = 392 * MiB;
constexpr size_t WS_GATES = 456 * MiB;
constexpr size_t WS_LSE = 457 * MiB;
constexpr size_t WS_NCH = 459 * MiB;
constexpr size_t WS_NPREV = WS_NCH + 512 * 1024;
constexpr size_t WS_SC = 460 * MiB;
constexpr size_t WS_GS = 460 * MiB + 65536;
constexpr size_t WS_KC = 462 * MiB;
constexpr size_t WS_END = 494 * MiB;
constexpr size_t DO_ATT = 0, DO_CPT = 96 * MiB;
constexpr int CW_BAR = 4096;
constexpr int CW_ROWSS = 65536;
static_assert((CW_ROWSS + T) * 4 <= (int)CTL_ZERO_BYTES && CW_BAR + 16 * 3456 <= CW_ROWSS, "CTL words inside the memset region");

constexpr int RING_BYTES = 131072;
constexpr int SM_OFF = 135168;
constexpr int LDSCTL_OFF = 143360, MISC_OFF = LDSCTL_OFF + 320;
constexpr int LDS_BYTES = 147456;
static_assert(MISC_OFF + 128 <= LDS_BYTES, "LDS map");

#define GAS __attribute__((address_space(1)))
#define LAS __attribute__((address_space(3)))
typedef unsigned short bf16;
typedef unsigned v4u __attribute__((ext_vector_type(4)));
typedef unsigned v2u __attribute__((ext_vector_type(2)));
typedef float f32x4 __attribute__((ext_vector_type(4)));
typedef short bf16x8 __attribute__((ext_vector_type(8)));
typedef short s16x4 __attribute__((ext_vector_type(4)));
typedef GAS unsigned gu32;
#define RLX_AGENT __ATOMIC_RELAXED, __HIP_MEMORY_SCOPE_AGENT
#define LDS_WAIT() asm volatile("s_waitcnt lgkmcnt(0)" ::: "memory")
#define VM_WAIT() asm volatile("s_waitcnt vmcnt(0)" ::: "memory")
#define LBAR() do { asm volatile("s_waitcnt lgkmcnt(0)" ::: "memory"); __builtin_amdgcn_s_barrier(); asm volatile("" ::: "memory"); } while (0)
__device__ __forceinline__ unsigned pk2(float lo, float hi) { return pg8::cvt_pk_bf16(lo, hi); }
__device__ __forceinline__ float bf_lo(unsigned u) { return __uint_as_float(u << 16); }
__device__ __forceinline__ float bf_hi(unsigned u) { return __uint_as_float(u & 0xffff0000u); }
__device__ __forceinline__ void unpack8(const v4u r, float* f) { f[0] = bf_lo(r.x); f[1] = bf_hi(r.x); f[2] = bf_lo(r.y); f[3] = bf_hi(r.y); f[4] = bf_lo(r.z); f[5] = bf_hi(r.z); f[6] = bf_lo(r.w); f[7] = bf_hi(r.w); }
__device__ __forceinline__ v4u pack8(const float* f) { v4u r; r.x = pk2(f[0], f[1]); r.y = pk2(f[2], f[3]); r.z = pk2(f[4], f[5]); r.w = pk2(f[6], f[7]); return r; }
__device__ __forceinline__ f32x4 mfma16(bf16x8 a, bf16x8 b, f32x4 c) { return __builtin_amdgcn_mfma_f32_16x16x32_bf16(a, b, c, 0, 0, 0); }
__device__ __forceinline__ s16x4 tr_read(LAS unsigned char* p) { return __builtin_amdgcn_ds_read_tr16_b64_v4i16((LAS s16x4*)p); }
__device__ __forceinline__ bf16x8 cat44(s16x4 lo, s16x4 hi) { return __builtin_shufflevector(lo, hi, 0, 1, 2, 3, 4, 5, 6, 7); }
__device__ __forceinline__ float siluf(float y) { return y * __builtin_amdgcn_rcpf(1.0f + __expf(-y)); }
__device__ __forceinline__ float sigmf(float y) { return __builtin_amdgcn_rcpf(1.0f + __expf(-y)); }
__device__ __forceinline__ const bf16* seg_ptr(const bf16* proj, int seg, int h) { return proj + (size_t)(seg * NH + h) * T * HD; }
__device__ __forceinline__ int kimg(int r, int ch) { return r * 256 + ((ch ^ (r & 15)) << 4); }
__device__ __forceinline__ int vimg(int r, int ch) { return r * 256 + ((ch ^ ((r & 7) << 1)) << 4); }
#define XB_TMO      128
#define XB_XCNT(j)  (256  + 64 * (j))
#define XB_XSUB(j)  (1280 + 64 * (j))
#define XB_XGEN(j)  (2304 + 64 * (j))
#define XB_TOP      3328
#define XB_TOPGEN   3392
#define XCD_BAR_WORDS 3456
#define XB_SPIN_CAP (1u << 18)

__device__ __forceinline__ unsigned xb_ld(unsigned* p)              { return __hip_atomic_load(p, __ATOMIC_RELAXED, __HIP_MEMORY_SCOPE_AGENT); }
__device__ __forceinline__ unsigned xb_add(unsigned* p, unsigned v) { return __hip_atomic_fetch_add(p, v, __ATOMIC_RELAXED, __HIP_MEMORY_SCOPE_AGENT); }
__device__ __forceinline__ unsigned xb_xcc_id() { return (unsigned)__builtin_amdgcn_s_getreg((3 << 11) | 20) & 0xFu; }
#define XB_SPIN(cond, bar) do { unsigned _sp = 0; while (cond) { __builtin_amdgcn_s_sleep(1); \
    if ((++_sp & 255u) == 0u) { if (xb_ld(&(bar)[XB_TMO])) break; if (_sp > XB_SPIN_CAP) { atomicAdd(&(bar)[XB_TMO], 1u); break; } } } } while (0)

struct XcdBarrier {
    unsigned* bar; unsigned x;
    volatile LAS unsigned* st;
};

__device__ __forceinline__ XcdBarrier xcd_barrier_post(unsigned* bar, volatile LAS unsigned* st) {
    XcdBarrier b; b.bar = bar; b.x = xb_xcc_id(); b.st = st;
    if (threadIdx.x == 0) (void)xb_add(&bar[XB_XCNT(b.x)], 1u);
    return b;
}
__device__ __forceinline__ void xcd_barrier_complete(unsigned* bar, unsigned x, unsigned& nloc, unsigned& nx) {
    const unsigned G = gridDim.x * gridDim.y * gridDim.z;
    unsigned sum, cnt, mine, sp = 0u;
    for (;;) {
        sum = 0u; cnt = 0u; mine = 0u;
#pragma unroll
        for (unsigned j = 0; j < 16; ++j) { const unsigned c = xb_ld(&bar[XB_XCNT(j)]); sum += c; cnt += (c > 0u) ? 1u : 0u; mine = (j == x) ? c : mine; }
        if (sum == G) break;
        __builtin_amdgcn_s_sleep(1);
        if ((++sp & 255u) == 0u) { if (xb_ld(&bar[XB_TMO])) break; if (sp > XB_SPIN_CAP) { atomicAdd(&bar[XB_TMO], 1u); break; } }
    }
    nloc = mine > 0u ? mine : 1u; nx = cnt > 0u ? cnt : 1u;
}

__device__ __forceinline__ void xcd_barrier(const XcdBarrier& b) {
    asm volatile("s_waitcnt vmcnt(0)" ::: "memory");
    __syncthreads();
    if (threadIdx.x == 0) {
        unsigned* bar = b.bar;
        __builtin_amdgcn_s_waitcnt(0);
        unsigned nloc = b.st[0], nx = b.st[1];
        if (nloc == 0u) { xcd_barrier_complete(bar, b.x, nloc, nx); b.st[0] = nloc; b.st[1] = nx; }
        const unsigned old = xb_add(&bar[XB_XSUB(b.x)], 1u);
        const unsigned gen = old / nloc;
        if (old + 1u == (gen + 1u) * nloc) {
            __builtin_amdgcn_fence(__ATOMIC_RELEASE, "agent");
            asm volatile("s_waitcnt vmcnt(0)" ::: "memory");
            const unsigned og = xb_add(&bar[XB_TOP], 1u);
            const unsigned tg = og / nx;
            if (og + 1u == (tg + 1u) * nx) xb_add(&bar[XB_TOPGEN], 1u);
            else XB_SPIN(xb_ld(&bar[XB_TOPGEN]) == tg, bar);
            __builtin_amdgcn_fence(__ATOMIC_ACQUIRE, "agent");
            xb_add(&bar[XB_XGEN(b.x)], 1u);
            asm volatile("s_waitcnt vmcnt(0)" ::: "memory");
        } else {
            XB_SPIN(xb_ld(&bar[XB_XGEN(b.x)]) == gen, bar);
            __builtin_amdgcn_fence(__ATOMIC_ACQUIRE, "agent");
            asm volatile("s_waitcnt vmcnt(0)" ::: "memory");
        }
    }
    __syncthreads();
}

__device__ __forceinline__ float wave_sum(float v) {
#pragma unroll
    for (int o = 1; o < 64; o <<= 1) v += __shfl_xor(v, o);
    return v;
}
struct TItem { const float* W; const float* ksc; bf16* WT; int ldw, K, mode, k0, n0; };
__device__ __forceinline__ void p0_load(const TItem& t, f32x4 (&v)[8], int lane) {
    const float* p = t.W + (size_t)(t.k0 + (lane >> 3)) * t.ldw + t.n0 + 4 * (lane & 7);
#pragma unroll
    for (int i = 0; i < 8; ++i) v[i] = *(const f32x4*)(p + (size_t)(8 * i) * t.ldw);
}
__device__ __forceinline__ void p0_emit(const TItem& t, const f32x4 (&v)[8], LAS float* scr, int lane) {
#pragma unroll
    for (int i = 0; i < 8; ++i) { const int kk = 8 * i + (lane >> 3); f32x4 y = v[i]; if (t.ksc) y = y * t.ksc[t.k0 + kk];
        LAS float* d = scr + kk * 33 + 4 * (lane & 7); d[0] = y.x; d[1] = y.y; d[2] = y.z; d[3] = y.w; }
    LDS_WAIT(); asm volatile("" ::: "memory");
    const int c = lane & 7;
    int nbase = t.n0; if (t.mode) nbase = ((t.n0 >> 7) << 8) + (t.n0 & 127) + (t.mode == 2 ? 128 : 0);
#pragma unroll
    for (int j = 0; j < 4; ++j) { const int n = (lane >> 3) + 8 * j; const LAS float* s = scr + (8 * c) * 33 + n;
        v4u o; o.x = pk2(s[0 * 33], s[1 * 33]); o.y = pk2(s[2 * 33], s[3 * 33]); o.z = pk2(s[4 * 33], s[5 * 33]); o.w = pk2(s[6 * 33], s[7 * 33]);
        *(GAS v4u*)(t.WT + (size_t)(nbase + n) * t.K + t.k0 + 8 * c) = o; }
    LDS_WAIT(); asm volatile("" ::: "memory");
}
constexpr int P0_SCR = 8448, P0_WG = 69632;
__device__ __forceinline__ int wgimg(int gate, int c) { return P0_WG + gate * 4096 + ((c ^ gate) << 4); }
template <int PARTS> __device__ __forceinline__ void p0_prologue(LAS unsigned char* lds, LAS float* sm, const float* const* in, unsigned char* ws, int vcu, int G, int tid, int lane, int wave) {
    const float* w_in = in[2]; const float* w_out = in[9]; const float* nfg = in[10]; const float* w_gate = in[11]; const float* w_up = in[12]; const float* w_down = in[13];
    {   float f[8][8];
#pragma unroll
        for (int i = 0; i < 8; ++i) { const int pr = tid + i * NWAVES * 64, gate = pr & 15, c = pr >> 4;
#pragma unroll
            for (int j = 0; j < 8; ++j) f[i][j] = w_in[(size_t)(8 * c + j) * INW + PJ + gate]; }
#pragma unroll
        for (int i = 0; i < 8; ++i) { const int pr = tid + i * NWAVES * 64, gate = pr & 15, c = pr >> 4; *(LAS v4u*)(lds + wgimg(gate, c)) = pack8(f[i]); }
    }
    LAS float* scr = (LAS float*)(lds + wave * P0_SCR);
    const int gw = vcu * NWAVES + wave, NGW = G * NWAVES;
    bf16* WIN = (bf16*)(ws + WS_WIN); bf16* WOUT = (bf16*)(ws + WS_WOUT); bf16* WGU = (bf16*)(ws + WS_WGU); bf16* WDN = (bf16*)(ws + WS_WDN);
    constexpr int I_IN = (DM / 64) * (PJ / 32), I_OUT = (DM / 64) * (DM / 32), I_G = (DM / 64) * (FF / 32), I_D = (FF / 64) * (DM / 32);
    constexpr int NITEMS = I_IN + I_OUT + 2 * I_G + I_D;
    auto decode = [&](int it) -> TItem {
        TItem t; int r = it, nblk;
        if (r < I_IN) { t.W = w_in; t.ldw = INW; nblk = PJ / 32; t.K = DM; t.WT = WIN; t.ksc = nullptr; t.mode = 0; }
        else if ((r -= I_IN) < I_OUT) { t.W = w_out; t.ldw = DM; nblk = DM / 32; t.K = DM; t.WT = WOUT; t.ksc = nullptr; t.mode = 0; }
        else if ((r -= I_OUT) < I_G) { t.W = w_gate; t.ldw = FF; nblk = FF / 32; t.K = DM; t.WT = WGU; t.ksc = nfg; t.mode = 1; }
        else if ((r -= I_G) < I_G) { t.W = w_up; t.ldw = FF; nblk = FF / 32; t.K = DM; t.WT = WGU; t.ksc = nfg; t.mode = 2; }
        else { r -= I_G; t.W = w_down; t.ldw = DM; nblk = DM / 32; t.K = FF; t.WT = WDN; t.ksc = nullptr; t.mode = 0; }
        const int kb = r / nblk; t.k0 = 64 * kb; t.n0 = 32 * (r - kb * nblk); return t; };
    if (PARTS & 1) {
        int it = gw; f32x4 va[8], vb[8]; TItem ta, tb;
        if (it < NITEMS) { ta = decode(it); p0_load(ta, va, lane); }
        while (it < NITEMS) {
            int itn = it + NGW; if (itn < NITEMS) { tb = decode(itn); p0_load(tb, vb, lane); }
            p0_emit(ta, va, scr, lane);
            it = itn; if (it >= NITEMS) break;
            itn = it + NGW; if (itn < NITEMS) { ta = decode(itn); p0_load(ta, va, lane); }
            p0_emit(tb, vb, scr, lane);
            it = itn;
        }
    }
    const float* x = in[0]; const float* nmg = in[1]; const float* gate_b = in[5];
    bf16* HB = (bf16*)(ws + WS_HB); float* GATES = (float*)(ws + WS_GATES);
    f32x4 gn[8];
#pragma unroll
    for (int j = 0; j < 8; ++j) gn[j] = *((const f32x4*)nmg + lane + 64 * j);
    if (PARTS & 2) for (int rg = vcu; rg < T / 64; rg += G) {
        const int m0 = rg * 64 + 8 * wave;
        f32x4 nv[8];
        { const GAS f32x4* xr = (const GAS f32x4*)(x + (size_t)m0 * DM) + lane;
#pragma unroll
          for (int j = 0; j < 8; ++j) nv[j] = xr[64 * j]; }
#pragma unroll 1
        for (int i = 0; i < 8; ++i) {
            f32x4 v[8]; float s = 0.f;
#pragma unroll
            for (int j = 0; j < 8; ++j) { v[j] = nv[j]; s += (v[j].x * v[j].x + v[j].y * v[j].y) + (v[j].z * v[j].z + v[j].w * v[j].w); }
            if (i < 7) { const GAS f32x4* xr = (const GAS f32x4*)(x + (size_t)(m0 + i + 1) * DM) + lane;
#pragma unroll
                for (int j = 0; j < 8; ++j) nv[j] = xr[64 * j]; }
            const float rstd = 1.0f / sqrtf(wave_sum(s) * (1.f / DM) + EPS);
            GAS unsigned long long* o8 = (GAS unsigned long long*)(HB + (size_t)(m0 + i) * DM) + lane;
#pragma unroll
            for (int j = 0; j < 8; ++j) { const f32x4 y = v[j] * rstd * gn[j]; o8[64 * j] = (unsigned long long)pk2(y.x, y.y) | ((unsigned long long)pk2(y.z, y.w) << 32); }
        }
        VM_WAIT(); __syncthreads();
        {
            const int x16 = lane & 15, g = lane >> 4, q = wave >> 1, kh = wave & 1;
            const bf16* hp = HB + (size_t)(rg * 64 + 16 * q + x16) * DM + 1024 * kh + 8 * g;
            f32x4 acc = (f32x4){0.f, 0.f, 0.f, 0.f};
#pragma unroll 8
            for (int s = 0; s < 32; ++s) {
                const bf16x8 bq = __builtin_bit_cast(bf16x8, *(const v4u*)(hp + 32 * s));
                const bf16x8 a = *(const LAS bf16x8*)(lds + wgimg(x16, 128 * kh + 4 * s + g));
                acc = mfma16(a, bq, acc);
            }
            if (kh) *(LAS f32x4*)(sm + (q * 64 + lane) * 4) = acc;
            __syncthreads();
            if (!kh) { const f32x4 o = *(const LAS f32x4*)(sm + (q * 64 + lane) * 4); const f32x4 gb = *(const f32x4*)(gate_b + 4 * g);
                *(f32x4*)(GATES + (size_t)(rg * 64 + 16 * q + x16) * 16 + 4 * g) = acc + o + gb; }
            __syncthreads();
        }
    }
}

struct AttnP { int b, h, dil, gi, r, n; };
__device__ __forceinline__ AttnP attn_decode(int L) {
    const int xc = (L & 255) >> 5, jj = L & 31, ii = L >> 8, qx = jj + 32 * ii;
    const int bh = 4 * xc + qx / 96, rem = qx % 96, gi = rem >> 5, i32 = rem & 31, sh = 2 * gi;
    AttnP p; p.gi = gi; p.dil = 1 << sh; p.b = bh >> 3; p.h = bh & 7; p.r = i32 & (p.dil - 1); p.n = i32 >> sh; return p;
}
__device__ __forceinline__ void attn_prefetch_k(const bf16* proj, const AttnP& p, int tid, v4u (&kr)[8]) {
    const unsigned vo = (unsigned)((tid >> 4) * p.dil * HD + (tid & 15) * 8) * 2u;
#pragma unroll
    for (int it = 0; it < 8; ++it) {
        const int ci = 128 * (p.n - 1) + it * 32 + ((p.n == 0 && it < 4) ? 128 : 0);
        const char* sb = (const char*)(seg_ptr(proj, S_AK, p.h) + ((size_t)p.b * SEQ + (size_t)ci * p.dil + p.r) * HD);
        kr[it] = *(const v4u*)(sb + vo);
    }
}
__device__ __forceinline__ void attn_load_q(const bf16* proj, const AttnP& p, int lane, int w, v4u (&qr)[4]) {
    const char* qb = (const char*)(seg_ptr(proj, S_AQ, p.h) + ((size_t)p.b * SEQ + (size_t)(128 * p.n + 16 * w) * p.dil + p.r) * HD);
    const unsigned qo = (unsigned)((lane & 15) * p.dil * HD + 8 * (lane >> 4)) * 2u;
#pragma unroll
    for (int s = 0; s < 4; ++s) qr[s] = *(const v4u*)(qb + qo + 64 * s);
}
__device__ __forceinline__ void attn_prefetch_v(const bf16* proj, const AttnP& p, int tid, v4u (&vr)[8]) {
    const unsigned vo = (unsigned)((tid >> 4) * p.dil * HD + (tid & 15) * 8) * 2u;
#pragma unroll
    for (int it = 0; it < 8; ++it) {
        const int ci = 128 * (p.n - 1) + it * 32 + ((p.n == 0 && it < 4) ? 128 : 0);
        const char* sb = (const char*)(seg_ptr(proj, S_AV, p.h) + ((size_t)p.b * SEQ + (size_t)ci * p.dil + p.r) * HD);
        vr[it] = *(const v4u*)(sb + vo);
    }
}
__device__ __forceinline__ void attn_stage(LAS unsigned char* lds, const AttnP& p, int tid, const v4u (&kr)[8], const v4u (&vr)[8], const v4u (&qr)[4], bf16x8 (&qf)[4]) {
    const int ch = tid & 15;
#pragma unroll
    for (int it = 0; it < 8; ++it) {
        const int row = it * 32 + (tid >> 4); const bool ok = (128 * (p.n - 1) + row) >= 0;
        v4u ko = kr[it], vo = vr[it];
        if (!ok) { ko = (v4u){0u, 0u, 0u, 0u}; vo = (v4u){0u, 0u, 0u, 0u}; }
        *(LAS v4u*)(lds + kimg(row, ch)) = ko;
        *(LAS v4u*)(lds + 65536 + vimg(row, ch)) = vo;
    }
#pragma unroll
    for (int s = 0; s < 4; ++s) qf[s] = __builtin_bit_cast(bf16x8, qr[s]);
}
template <bool FIRST, int MODE = 0> __device__ __forceinline__ void attn_compute(LAS unsigned char* lds, const AttnP& p, const bf16x8 (&qf)[4], float cb, bf16* og, float* osum, int lane, int w) {
    const int x = lane & 15, g = lane >> 4, n = p.n, q4 = x >> 2, p2 = x & 3;
    const size_t tq = (size_t)p.b * SEQ + (size_t)(128 * n + 16 * w + x) * p.dil + p.r;
    const int start = w < 6 ? w : 6;
    int kbase[4], vbase[8];
#pragma unroll
    for (int s = 0; s < 4; ++s) kbase[s] = (start * 16 + x) * 256 + (((4 * s + g) ^ x) << 4);
#pragma unroll
    for (int eb = 0; eb < 8; ++eb) vbase[eb] = 65536 + (start * 16 + 4 * g + q4) * 256 + (((2 * eb + (p2 >> 1)) ^ (((4 * g + q4) & 7) << 1)) << 4) + 8 * (p2 & 1);
    f32x4 oacc[8];
#pragma unroll
    for (int eb = 0; eb < 8; ++eb) oacc[eb] = (f32x4){0.f, 0.f, 0.f, 0.f};
    const int qrel = 16 * w + x; float sum = 0.f;
    bf16x8 ka[2][4];
#pragma unroll
    for (int h2 = 0; h2 < 2; ++h2)
#pragma unroll
        for (int s = 0; s < 4; ++s) ka[h2][s] = *(const LAS bf16x8*)(lds + kbase[s] + h2 * 4096);
#pragma unroll
    for (int i = 0; i < 5; ++i) {
        s16x4 va[8][2];
#pragma unroll
        for (int eb = 0; eb < 8; ++eb) { va[eb][0] = tr_read(lds + vbase[eb] + i * 8192); va[eb][1] = tr_read(lds + vbase[eb] + i * 8192 + 4096); }
        f32x4 sc[2];
#pragma unroll
        for (int h2 = 0; h2 < 2; ++h2) { sc[h2] = (f32x4){0.f, 0.f, 0.f, 0.f};
#pragma unroll
            for (int s = 0; s < 4; ++s) sc[h2] = mfma16(ka[h2][s], qf[s], sc[h2]); }
        if (i < 4) {
#pragma unroll
            for (int h2 = 0; h2 < 2; ++h2)
#pragma unroll
                for (int s = 0; s < 4; ++s) ka[h2][s] = *(const LAS bf16x8*)(lds + kbase[s] + (2 * i + 2 + h2) * 4096);
        }
        float pe[2][4];
#pragma unroll
        for (int h2 = 0; h2 < 2; ++h2)
#pragma unroll
            for (int q = 0; q < 4; ++q) {
                float e = __builtin_amdgcn_exp2f(sc[h2][q] - cb);
                if (FIRST || i == 0 || i == 4) { const int kr = (start + 2 * i + h2) * 16 + 4 * g + q - 128, dist = qrel - kr; const bool valid = (dist >= 0) && (dist <= 128) && (!FIRST || kr >= 0); e = valid ? e : 0.f; }
                pe[h2][q] = e; sum += e; }
        v4u pw; pw.x = pk2(pe[0][0], pe[0][1]); pw.y = pk2(pe[0][2], pe[0][3]); pw.z = pk2(pe[1][0], pe[1][1]); pw.w = pk2(pe[1][2], pe[1][3]);
        const bf16x8 pf = __builtin_bit_cast(bf16x8, pw);
#pragma unroll
        for (int eb = 0; eb < 8; ++eb) oacc[eb] = mfma16(cat44(va[eb][0], va[eb][1]), pf, oacc[eb]);
    }
    sum += __shfl_xor(sum, 16); sum += __shfl_xor(sum, 32);
    const float inv = 1.0f / sum;
    bf16* op = og + ((size_t)(p.gi * NH + p.h) * T + tq) * HD + 4 * g;
#pragma unroll
    for (int eb = 0; eb < 8; ++eb) { v2u o; o.x = pk2(oacc[eb][0] * inv, oacc[eb][1] * inv); o.y = pk2(oacc[eb][2] * inv, oacc[eb][3] * inv); if (MODE == 0) *(v2u*)(op + 16 * eb) = o; else asm volatile("" :: "v"(o.x), "v"(o.y)); }
    if (MODE == 0) { if (g == 0) osum[(size_t)(p.gi * NH + p.h) * T + tq] = sum; }
}
template <int MODE = 0> __device__ __forceinline__ void attn_phase(LAS unsigned char* lds, const bf16* proj, bf16* og, float* osum, const float* __restrict__ qg, const float* __restrict__ kg, int vcu, int G, int tid, int lane, int w) {
    int L = vcu; if (L >= 3072) return;
    float cb;
    { float mq = fmaxf(fabsf(qg[lane]), fabsf(qg[lane + 64])), mk = fmaxf(fabsf(kg[lane]), fabsf(kg[lane + 64]));
#pragma unroll
      for (int o = 32; o >= 1; o >>= 1) { mq = fmaxf(mq, __shfl_xor(mq, o)); mk = fmaxf(mk, __shfl_xor(mk, o)); }
      cb = 11.313708499f * mq * mk * LOG2E; }
    AttnP p = attn_decode(L);
    v4u kr[8], vr[8], qr[4];
    attn_prefetch_k(proj, p, tid, kr); attn_prefetch_v(proj, p, tid, vr); attn_load_q(proj, p, lane, w, qr);
    for (;;) {
        bf16x8 qf[4];
        attn_stage(lds, p, tid, kr, vr, qr, qf);
        LBAR();
        const int Ln = L + G; const bool more = Ln < 3072;
        const AttnP pn = attn_decode(more ? Ln : L);
        if (MODE != 2) { attn_prefetch_k(proj, pn, tid, kr); attn_prefetch_v(proj, pn, tid, vr); attn_load_q(proj, pn, lane, w, qr); }
        if (MODE != 1) { if (p.n == 0) attn_compute<true, MODE>(lds, p, qf, cb, og, osum, lane, w); else attn_compute<false, MODE>(lds, p, qf, cb, og, osum, lane, w); }
        LBAR();
        if (!more) break;
        p = pn; L = Ln;
    }
}

__device__ __forceinline__ void gate_prepass(const float* gates, float* gs, float* sc, int idx, int lane) {
    const int c = idx & 31, bh = idx >> 5, h = bh & 7, b = bh >> 3;
    const size_t t0 = (size_t)b * SEQ + 128 * c;
    const float* g0 = gates + (t0 + lane) * 16, * g1 = gates + (t0 + 64 + lane) * 16;
    const float i0 = g0[h], f0 = g0[8 + h], i1 = g1[h], f1 = g1[8 + h];
    float v0 = fminf(f0, 0.f) - log1pf(expf(-fabsf(f0))), v1 = fminf(f1, 0.f) - log1pf(expf(-fabsf(f1)));
#pragma unroll
    for (int o = 1; o < 64; o <<= 1) { const float a0 = __shfl_up(v0, o), a1 = __shfl_up(v1, o); if (lane >= o) { v0 += a0; v1 += a1; } }
    v1 += __shfl(v0, 63);
    const float u0 = i0 - v0, u1 = i1 - v1;
    float m = fmaxf(u0, u1);
#pragma unroll
    for (int o = 32; o >= 1; o >>= 1) m = fmaxf(m, __shfl_xor(m, o));
    float* gp = gs + (size_t)idx * 256;
    gp[lane] = v0; gp[64 + lane] = v1; gp[128 + lane] = u0; gp[192 + lane] = u1;
    if (lane == 63) { sc[idx] = v1; sc[1024 + idx] = v1 + m; sc[3072 + idx] = m; }
}
__device__ __forceinline__ void load_conv_w(const float* __restrict__ convw, const float* __restrict__ convb, int cc, float (&cw)[4][8], float (&cb)[8]) {
#pragma unroll
    for (int tap = 0; tap < 4; ++tap) { const f32x4 a = *(const f32x4*)(convw + tap * 2048 + cc), c = *(const f32x4*)(convw + tap * 2048 + cc + 4);
        cw[tap][0] = a.x; cw[tap][1] = a.y; cw[tap][2] = a.z; cw[tap][3] = a.w; cw[tap][4] = c.x; cw[tap][5] = c.y; cw[tap][6] = c.z; cw[tap][7] = c.w; }
    const f32x4 a = *(const f32x4*)(convb + cc), c = *(const f32x4*)(convb + cc + 4);
    cb[0] = a.x; cb[1] = a.y; cb[2] = a.z; cb[3] = a.w; cb[4] = c.x; cb[5] = c.y; cb[6] = c.z; cb[7] = c.w;
}
__device__ __forceinline__ void stage_conv_w(LAS float* sm, const float* __restrict__ convw, const float* __restrict__ convb, int h, int tid) {
    for (int i = tid; i < 1280; i += NWAVES * 64) { const int path = i / 640, r = i - path * 640, tap = r >> 7, d = r & 127, cc = (path == 0 ? 1024 : 0) + h * 128 + d;
        sm[i] = tap < 4 ? convw[tap * 2048 + cc] : convb[cc]; }
}
__device__ __forceinline__ void load_conv_w_lds(const LAS float* sm, int path, int ch, float (&cw)[4][8], float (&cb)[8]) {
#pragma unroll
    for (int tap = 0; tap < 4; ++tap) { const f32x4 a = *(const LAS f32x4*)(sm + path * 640 + tap * 128 + ch * 8), c = *(const LAS f32x4*)(sm + path * 640 + tap * 128 + ch * 8 + 4);
        cw[tap][0] = a.x; cw[tap][1] = a.y; cw[tap][2] = a.z; cw[tap][3] = a.w; cw[tap][4] = c.x; cw[tap][5] = c.y; cw[tap][6] = c.z; cw[tap][7] = c.w; }
    const f32x4 a = *(const LAS f32x4*)(sm + path * 640 + 512 + ch * 8), c = *(const LAS f32x4*)(sm + path * 640 + 512 + ch * 8 + 4);
    cb[0] = a.x; cb[1] = a.y; cb[2] = a.z; cb[3] = a.w; cb[4] = c.x; cb[5] = c.y; cb[6] = c.z; cb[7] = c.w;
}
__device__ __forceinline__ void conv4x8(const v4u (&raw)[7], const float (&cw)[4][8], const float (&cb)[8], float (&y)[4][8]) {
#pragma unroll
    for (int i = 0; i < 4; ++i)
#pragma unroll
        for (int j = 0; j < 8; ++j) y[i][j] = cb[j];
#pragma unroll
    for (int r = 0; r < 7; ++r) { float f[8]; unpack8(raw[r], f);
#pragma unroll
        for (int i = 0; i < 4; ++i) { const int tap = r - i; if (tap >= 0 && tap < 4) {
#pragma unroll
            for (int j = 0; j < 8; ++j) y[i][j] += f[j] * cw[tap][j]; } } }
#pragma unroll
    for (int i = 0; i < 4; ++i)
#pragma unroll
        for (int j = 0; j < 8; ++j) y[i][j] = siluf(y[i][j]);
}

struct MARegs { v4u kraw[7], qraw[7], vr[4]; f32x4 u4; float umax; };
__device__ __forceinline__ void mA_prefetch(const bf16* proj, const float* gs, const float* sc, int idx, int tid, MARegs& R) {
    const int c = idx & 31, bh = idx >> 5, h = bh & 7, b = bh >> 3, rg = tid >> 4, ch = tid & 15;
    const size_t t0 = (size_t)b * SEQ + 128 * c;
    const bf16* bk3 = seg_ptr(proj, S_MK, h) + (t0 - 3) * HD, * bq3 = seg_ptr(proj, S_MQ, h) + (t0 - 3) * HD, * bv = seg_ptr(proj, S_MV, h) + t0 * HD;
    const int lo = (c == 0) ? 3 : 0;
#pragma unroll
    for (int j = 0; j < 7; ++j) { int row3 = 4 * rg + j; row3 = row3 < lo ? lo : row3;
        const unsigned vo = (unsigned)(row3 * HD + ch * 8) * 2u;
        R.kraw[j] = *(const v4u*)((const char*)bk3 + vo); R.qraw[j] = *(const v4u*)((const char*)bq3 + vo); }
    const unsigned vo = (unsigned)(4 * rg * HD + ch * 8) * 2u;
#pragma unroll
    for (int i = 0; i < 4; ++i) R.vr[i] = *(const v4u*)((const char*)(bv + i * HD) + vo);
    R.u4 = *(const f32x4*)(gs + (size_t)idx * 256 + 128 + 4 * rg);
    R.umax = __hip_atomic_load(sc + 3072 + idx, __ATOMIC_RELAXED, __HIP_MEMORY_SCOPE_AGENT);
}
__device__ __forceinline__ void mlstmA_phase(LAS unsigned char* lds, LAS float* sm, const bf16* proj, const float* gates, const float* __restrict__ convw, const float* __restrict__ convb,
                                             bf16* kvt, float* nch, float* sc, float* gs, bf16* kc, bf16* mix, int vcu, int G, int tid, int lane, int w) {
    if (vcu >= 1024) return;
    for (int idx = vcu + G * w; idx < 1024; idx += G * NWAVES) gate_prepass(gates, gs, sc, idx, lane);
    int hcur = (vcu >> 5) & 7; stage_conv_w(sm, convw, convb, hcur, tid);
    VM_WAIT(); __syncthreads();
    int idx = vcu;
    MARegs R; mA_prefetch(proj, gs, sc, idx, tid, R);
    const int x = lane & 15, g = lane >> 4, rg = tid >> 4, ch = tid & 15;
    for (;;) {
        const int c = idx & 31, bh = idx >> 5, h = bh & 7, b = bh >> 3;
        const size_t t0 = (size_t)b * SEQ + 128 * c;
        if (h != hcur) { hcur = h; stage_conv_w(sm, convw, convb, hcur, tid); VM_WAIT(); LBAR(); }
        if (c == 0 && rg == 0) {
#pragma unroll
            for (int j = 0; j < 3; ++j) { R.kraw[j] = (v4u){0u, 0u, 0u, 0u}; R.qraw[j] = (v4u){0u, 0u, 0u, 0u}; } }
        {
            float cw[4][8], cb[8]; load_conv_w_lds(sm, 0, ch, cw, cb);
            float y[4][8]; conv4x8(R.kraw, cw, cb, y);
#pragma unroll
            for (int i = 0; i < 4; ++i) { const int l = 4 * rg + i; const float wa = __expf(R.u4[i] - R.umax);
#pragma unroll
                for (int j = 0; j < 8; ++j) y[i][j] *= RSQRT_HD;
                *(v4u*)(kc + ((size_t)h * T + t0 + l) * HD + ch * 8) = pack8(y[i]);
#pragma unroll
                for (int j = 0; j < 8; ++j) y[i][j] *= wa;
                *(LAS v4u*)(lds + vimg(l, ch)) = pack8(y[i]); }
        }
        {
            float cw[4][8], cb[8]; load_conv_w_lds(sm, 1, ch, cw, cb);
            float y[4][8]; conv4x8(R.qraw, cw, cb, y);
#pragma unroll
            for (int i = 0; i < 4; ++i) *(v4u*)(mix + (t0 + 4 * rg + i) * DM + AW + h * 128 + ch * 8) = pack8(y[i]);
        }
#pragma unroll
        for (int i = 0; i < 4; ++i) *(LAS v4u*)(lds + 32768 + vimg(4 * rg + i, ch)) = R.vr[i];
        LBAR();
        const int idn = idx + G; const bool more = idn < 1024;
        mA_prefetch(proj, gs, sc, more ? idn : idx, tid, R);
        f32x4 acc[8], accn = (f32x4){0.f, 0.f, 0.f, 0.f};
#pragma unroll
        for (int db = 0; db < 8; ++db) acc[db] = (f32x4){0.f, 0.f, 0.f, 0.f};
        const int q4 = x >> 2, p2 = x & 3;
        const int xr = ((4 * g + q4) & 7) << 1;
        const int rowb = (4 * g + q4) * 256 + 8 * (p2 & 1);
        int vbase = 32768 + rowb + (((2 * w + (p2 >> 1)) ^ xr) << 4), kb[8];
#pragma unroll
        for (int db = 0; db < 8; ++db) kb[db] = rowb + (((2 * db + (p2 >> 1)) ^ xr) << 4);
        const bf16x8 ones = (bf16x8){0x3F80, 0x3F80, 0x3F80, 0x3F80, 0x3F80, 0x3F80, 0x3F80, 0x3F80};
#pragma unroll
        for (int ks = 0; ks < 4; ++ks) {
            const bf16x8 vf = cat44(tr_read(lds + vbase + ks * 8192), tr_read(lds + vbase + ks * 8192 + 4096));
#pragma unroll
            for (int db = 0; db < 8; ++db) {
                const bf16x8 kf = cat44(tr_read(lds + kb[db] + ks * 8192), tr_read(lds + kb[db] + ks * 8192 + 4096));
                acc[db] = mfma16(kf, vf, acc[db]);
                if (db == w) accn = mfma16(kf, ones, accn);
            }
        }
        bf16* kp = kvt + (size_t)idx * 16384 + (size_t)(16 * w + x) * 128 + 4 * g;
#pragma unroll
        for (int db = 0; db < 8; ++db) { v2u o; o.x = pk2(acc[db][0], acc[db][1]); o.y = pk2(acc[db][2], acc[db][3]); *(v2u*)(kp + 16 * db) = o; }
        if (x == 0) *(f32x4*)(nch + (size_t)idx * 128 + 16 * w + 4 * g) = accn;
        LBAR();
        if (!more) break;
        idx = idn;
    }
}

__device__ __forceinline__ void p3_scan_merge(const bf16* kvt, const float* nch, float* sc, bf16* cpt, float* nprev, const bf16* og, const float* lse, bf16* mix, int vcu, int G, int tid) {
    const int gid = vcu * (NWAVES * 64) + tid, NT = G * NWAVES * 64;
    for (int task = gid; task < 32 * 2048; task += NT) {
        const int bh = task >> 11, f8 = task & 2047;
        float C[8]; float m = -1e30f;
#pragma unroll
        for (int j = 0; j < 8; ++j) C[j] = 0.f;
        for (int c = 0; c < 32; ++c) {
            const int idx = bh * 32 + c; const float bl = sc[idx], mc = sc[1024 + idx];
            *(v4u*)(cpt + (size_t)idx * 16384 + 8 * f8) = pack8(C);
            if (f8 == 0) sc[2048 + idx] = m;
            const float mn = fmaxf(bl + m, mc), decay = expf(bl + m - mn), scale = expf(mc - mn);
            float kv[8]; unpack8(*(const v4u*)(kvt + (size_t)idx * 16384 + 8 * f8), kv);
#pragma unroll
            for (int j = 0; j < 8; ++j) C[j] = C[j] * decay + kv[j] * scale;
            m = mn;
        }
    }
    for (int task = gid; task < 32 * 32; task += NT) {
        const int bh = task >> 5, f4 = task & 31;
        f32x4 C = (f32x4){0.f, 0.f, 0.f, 0.f}; float m = -1e30f;
        for (int c = 0; c < 32; ++c) {
            const int idx = bh * 32 + c; const float bl = sc[idx], mc = sc[1024 + idx];
            *(f32x4*)(nprev + (size_t)idx * 128 + 4 * f4) = C;
            const float mn = fmaxf(bl + m, mc), decay = expf(bl + m - mn), scale = expf(mc - mn);
            const f32x4 kv = *(const f32x4*)(nch + (size_t)idx * 128 + 4 * f4);
            C = C * decay + kv * scale; m = mn;
        }
    }
    for (int task = gid; task < T * NH * 16; task += NT) {
        const int t = task >> 7, rem = task & 127, h = rem >> 4, ch = rem & 15;
        float w0 = lse[(size_t)h * T + t], w1 = lse[(size_t)(NH + h) * T + t], w2 = lse[(size_t)(2 * NH + h) * T + t];
        const float inv = 1.0f / (w0 + w1 + w2); w0 *= inv; w1 *= inv; w2 *= inv;
        const size_t o = ((size_t)h * T + t) * HD + ch * 8;
        float a[8], bq[8], cq[8]; unpack8(*(const v4u*)(og + o), a); unpack8(*(const v4u*)(og + (size_t)NH * T * HD + o), bq); unpack8(*(const v4u*)(og + (size_t)2 * NH * T * HD + o), cq);
#pragma unroll
        for (int j = 0; j < 8; ++j) a[j] = a[j] * w0 + bq[j] * w1 + cq[j] * w2;
        *(v4u*)(mix + (size_t)t * DM + h * 128 + ch * 8) = pack8(a);
    }
}

struct MCRegs { v4u kr[4], vr[4], qr[4], cr[4]; float u[4], bq, npv, mprev, umax; };
__device__ __forceinline__ void mC_prefetch(const bf16* proj, const float* gs, const bf16* kc, const bf16* mix, const bf16* cpt, const float* nprev, const float* sc, int idx, int tid, int lane, int w, MCRegs& R) {
    const int c = idx & 31, bh = idx >> 5, h = bh & 7, b = bh >> 3, rg = tid >> 4, ch = tid & 15;
    const size_t t0 = (size_t)b * SEQ + 128 * c;
    const unsigned vk = (unsigned)(rg * HD + ch * 8) * 2u, vq = (unsigned)(rg * DM + ch * 8) * 2u;
#pragma unroll
    for (int it = 0; it < 4; ++it) {
        R.kr[it] = *(const v4u*)((const char*)(kc + ((size_t)h * T + t0 + 32 * it) * HD) + vk);
        R.vr[it] = *(const v4u*)((const char*)(seg_ptr(proj, S_MV, h) + (t0 + 32 * it) * HD) + vk);
        R.qr[it] = *(const v4u*)((const char*)(mix + (t0 + 32 * it) * DM + AW + h * 128) + vq);
        R.cr[it] = *(const v4u*)((const char*)(cpt + (size_t)idx * 16384 + 32 * it * 128) + vk);
        R.u[it] = gs[(size_t)idx * 256 + 128 + 32 * it + rg];
    }
    R.bq = gs[(size_t)idx * 256 + 16 * w + (lane & 15)];
    R.npv = 0.f; if (tid < 128) R.npv = nprev[(size_t)idx * 128 + tid];
    R.mprev = __hip_atomic_load(sc + 2048 + idx, __ATOMIC_RELAXED, __HIP_MEMORY_SCOPE_AGENT);
    R.umax = __hip_atomic_load(sc + 3072 + idx, __ATOMIC_RELAXED, __HIP_MEMORY_SCOPE_AGENT);
}
template <int MODE = 0> __device__ __forceinline__ void mlstmC_phase(LAS unsigned char* lds, LAS float* sm, const bf16* proj, const float* gs, const bf16* kc, const bf16* cpt, const float* nprev, const float* sc,
                                             const float* __restrict__ ng, bf16* mix, int vcu, int G, int tid, int lane, int w) {
    int idx = vcu; if (idx >= 1024) return;
    int hcur = (vcu >> 5) & 7; if (tid < 128) sm[640 + tid] = ng[hcur * 128 + tid];
    MCRegs R; mC_prefetch(proj, gs, kc, mix, cpt, nprev, sc, idx, tid, lane, w, R);
    const int x = lane & 15, g = lane >> 4, rg = tid >> 4, ch = tid & 15;
    for (;;) {
        const int c = idx & 31, bh = idx >> 5, h = bh & 7, b = bh >> 3;
        const size_t t0 = (size_t)b * SEQ + 128 * c;
        if (h != hcur) { hcur = h; LBAR(); if (tid < 128) sm[640 + tid] = ng[hcur * 128 + tid]; }
        const float mprev = R.mprev, M = fmaxf(mprev, R.umax), cs = __expf(mprev - M), fl = __expf(-(R.bq + M));
#pragma unroll
        for (int it = 0; it < 4; ++it) {
            const int l = it * 32 + rg;
            const float cf = __expf(R.u[it] - M);
            float y[8]; unpack8(R.kr[it], y);
#pragma unroll
            for (int j = 0; j < 8; ++j) y[j] *= cf;
            *(LAS v4u*)(lds + kimg(l, ch)) = pack8(y);
            *(LAS v4u*)(lds + 32768 + vimg(l, ch)) = R.vr[it];
            *(LAS v4u*)(lds + 65536 + kimg(l, ch)) = R.cr[it];
            *(LAS v4u*)(lds + 98304 + kimg(l, ch)) = R.qr[it];
        }
        if (tid < 128) sm[512 + tid] = R.npv;
        LBAR();
        const int idn = idx + G; const bool more = idn < 1024;
        if (MODE != 2) mC_prefetch(proj, gs, kc, mix, cpt, nprev, sc, more ? idn : idx, tid, lane, w, R);
        if (MODE == 1) { LBAR(); if (!more) break; idx = idn; continue; }
        const int lq = 16 * w + x;
        v2u mor[8];
        const int q4 = x >> 2, p2 = x & 3;
        int rb[4];
#pragma unroll
        for (int s = 0; s < 4; ++s) rb[s] = x * 256 + (((4 * s + g) ^ x) << 4);
        bf16x8 qf[4]; float qn = 0.f;
#pragma unroll
        for (int s = 0; s < 4; ++s) {
            qf[s] = *(const LAS bf16x8*)(lds + 98304 + w * 4096 + rb[s]);
            float y[8]; unpack8(__builtin_bit_cast(v4u, qf[s]), y);
#pragma unroll
            for (int j = 0; j < 8; ++j) qn += y[j] * sm[512 + 32 * s + 8 * g + j];
        }
        qn += __shfl_xor(qn, 16); qn += __shfl_xor(qn, 32);
        f32x4 acc[8];
#pragma unroll
        for (int eb = 0; eb < 8; ++eb) acc[eb] = (f32x4){0.f, 0.f, 0.f, 0.f};
#pragma unroll
        for (int s = 0; s < 4; ++s)
#pragma unroll
            for (int hf = 0; hf < 2; ++hf) {
                bf16x8 ca[4];
#pragma unroll
                for (int e4 = 0; e4 < 4; ++e4) ca[e4] = *(const LAS bf16x8*)(lds + 65536 + (4 * hf + e4) * 4096 + rb[s]);
#pragma unroll
                for (int e4 = 0; e4 < 4; ++e4) acc[4 * hf + e4] = mfma16(ca[e4], qf[s], acc[4 * hf + e4]);
            }
#pragma unroll
        for (int eb = 0; eb < 8; ++eb) acc[eb] = acc[eb] * cs;
        const int xr = ((4 * g + q4) & 7) << 1;
        int vb[8];
#pragma unroll
        for (int eb = 0; eb < 8; ++eb) vb[eb] = 32768 + (4 * g + q4) * 256 + 8 * (p2 & 1) + (((2 * eb + (p2 >> 1)) ^ xr) << 4);
        float dsum = 0.f;
        {
            const bf16* mo = seg_ptr(proj, S_MO, h) + (t0 + lq) * HD + 4 * g;
#pragma unroll
            for (int eb = 0; eb < 8; ++eb) mor[eb] = *(const v2u*)(mo + 16 * eb); }
#pragma unroll 1
        for (int i = 0; i < 4; ++i) {
            f32x4 sc2[2];
#pragma unroll
            for (int h2 = 0; h2 < 2; ++h2) { bf16x8 ka[4];
#pragma unroll
                for (int s = 0; s < 4; ++s) ka[s] = *(const LAS bf16x8*)(lds + (2 * i + h2) * 4096 + rb[s]);
                sc2[h2] = (f32x4){0.f, 0.f, 0.f, 0.f};
#pragma unroll
                for (int s = 0; s < 4; ++s) sc2[h2] = mfma16(ka[s], qf[s], sc2[h2]); }
            float pe[2][4];
#pragma unroll
            for (int h2 = 0; h2 < 2; ++h2)
#pragma unroll
                for (int q = 0; q < 4; ++q) { const float v = (16 * (2 * i + h2) + 4 * g + q <= lq) ? sc2[h2][q] : 0.f; pe[h2][q] = v; dsum += v; }
            v4u pw; pw.x = pk2(pe[0][0], pe[0][1]); pw.y = pk2(pe[0][2], pe[0][3]); pw.z = pk2(pe[1][0], pe[1][1]); pw.w = pk2(pe[1][2], pe[1][3]);
            const bf16x8 pf = __builtin_bit_cast(bf16x8, pw);
#pragma unroll
            for (int hf = 0; hf < 2; ++hf) {
                s16x4 va[4][2];
#pragma unroll
                for (int e4 = 0; e4 < 4; ++e4) { va[e4][0] = tr_read(lds + vb[4 * hf + e4] + i * 8192); va[e4][1] = tr_read(lds + vb[4 * hf + e4] + i * 8192 + 4096); }
#pragma unroll
                for (int e4 = 0; e4 < 4; ++e4) acc[4 * hf + e4] = mfma16(cat44(va[e4][0], va[e4][1]), pf, acc[4 * hf + e4]);
            }
        }
        dsum += __shfl_xor(dsum, 16); dsum += __shfl_xor(dsum, 32);
        const float den = cs * qn + dsum, inv = 1.0f / fmaxf(fabsf(den), fl);
        float ss = 0.f;
#pragma unroll
        for (int eb = 0; eb < 8; ++eb) { acc[eb] = acc[eb] * inv; ss += (acc[eb][0] * acc[eb][0] + acc[eb][1] * acc[eb][1]) + (acc[eb][2] * acc[eb][2] + acc[eb][3] * acc[eb][3]); }
        ss += __shfl_xor(ss, 16); ss += __shfl_xor(ss, 32);
        const float rstd = __builtin_amdgcn_rsqf(ss * (1.f / HD) + EPS);
        bf16* op = mix + (t0 + lq) * DM + AW + h * 128 + 4 * g;
        const LAS float* ngp = sm + 640 + 4 * g;
#pragma unroll
        for (int eb = 0; eb < 8; ++eb) {
            const v2u mr = mor[eb]; const f32x4 gv = *(const LAS f32x4*)(ngp + 16 * eb);
            const float o0 = acc[eb][0] * rstd * gv.x * sigmf(bf_lo(mr.x)), o1 = acc[eb][1] * rstd * gv.y * sigmf(bf_hi(mr.x)), o2 = acc[eb][2] * rstd * gv.z * sigmf(bf_lo(mr.y)), o3 = acc[eb][3] * rstd * gv.w * sigmf(bf_hi(mr.y));
            v2u o; o.x = pk2(o0, o1); o.y = pk2(o2, o3); if (MODE == 0) *(v2u*)(op + 16 * eb) = o; else asm volatile("" :: "v"(o.x), "v"(o.y));
        }
        LBAR();
        if (!more) break;
        idx = idn;
    }
}

struct Args { const float* in[14]; float* out; unsigned char* ws; int ph_lo, ph_hi, li, pad; };
__global__ void __launch_bounds__(NWAVES * 64, 2) hyb_fwd(Args args) {
    extern __shared__ __attribute__((aligned(16))) unsigned char lds_raw[];
    LAS unsigned char* lds = (LAS unsigned char*)lds_raw;
    volatile LAS unsigned* MISC = (volatile LAS unsigned*)(lds + MISC_OFF);
    LAS float* sm = (LAS float*)(lds + SM_OFF);
    const int tid = threadIdx.x, lane = tid & 63, wave = __builtin_amdgcn_readfirstlane(tid >> 6);
    const int G = gridDim.x; const int bx = blockIdx.x; const int vcu = (G % 8 == 0) ? (bx % 8) * (G / 8) + bx / 8 : bx;
    unsigned char* ws = args.ws;
    gu32* ctl = (gu32*)(ws + WS_CTL);
    for (int u = tid; u < (LDS_BYTES - LDSCTL_OFF) / 4; u += NWAVES * 64) ((LAS unsigned*)(lds + LDSCTL_OFF))[u] = 0u;
    __syncthreads();
    const XcdBarrier bar = xcd_barrier_post((unsigned*)(ctl + CW_BAR) + args.li * XCD_BAR_WORDS, MISC + 8);
#define GRID_BAR() xcd_barrier(bar)
#ifdef PROBE_T
#define STAMP(k) do { if (bx == 0 && tid == 0) MISC[16 + (k)] = (unsigned)wall_clock64(); } while (0)
#else
#define STAMP(k) do { } while (0)
#endif
    STAMP(0);
    const int lo = args.ph_lo, hi = args.ph_hi;
#ifndef PH_MASK
#define PH_MASK 0xffffff
#endif
#define IN(k) (((PH_MASK >> (k)) & 1) && lo <= (k) && (k) < hi)
#define BOTH(k) (IN(k) && IN((k) + 1))

    bf16* WIN = (bf16*)(ws + WS_WIN); bf16* WOUT = (bf16*)(ws + WS_WOUT); bf16* WGU = (bf16*)(ws + WS_WGU); bf16* WDN = (bf16*)(ws + WS_WDN);
    bf16* HB = (bf16*)(ws + WS_HB); bf16* KVT = (bf16*)(ws + WS_HB); bf16* PROJ = (bf16*)(ws + WS_PROJ); bf16* HID = (bf16*)(ws + WS_PROJ); bf16* MIX = (bf16*)(ws + WS_MIX);
    float* GATES = (float*)(ws + WS_GATES); float* LSE = (float*)(ws + WS_LSE); float* NCHK = (float*)(ws + WS_NCH); float* NPREV = (float*)(ws + WS_NPREV); float* SC = (float*)(ws + WS_SC);
    float* ROWSS = (float*)(ws + WS_CTL) + CW_ROWSS; bf16* KC = (bf16*)(ws + WS_KC); float* GS = (float*)(ws + WS_GS);
    bf16* OG = (bf16*)((unsigned char*)args.out + DO_ATT); bf16* CPT = (bf16*)((unsigned char*)args.out + DO_CPT);

    if (IN(0)) { p0_prologue<3>(lds, sm, args.in, ws, vcu, G, tid, lane, wave); if (BOTH(0)) GRID_BAR(); STAMP(1); }
#ifdef PROBE_P0
    if (IN(8)) p0_prologue<1>(lds, sm, args.in, ws, vcu, G, tid, lane, wave);
    if (IN(9)) p0_prologue<2>(lds, sm, args.in, ws, vcu, G, tid, lane, wave);
#endif

    if (IN(1)) {
        pg8::Gemm g{HB, WIN, T, PJ, DM}; pg8::StaticOrder S; S.init(T, PJ, G, bx);
        pg8::EpiProj E{PROJ, T, args.in[6], args.in[7], sm, EPS, RSQRT_HD * LOG2E};
        pg8::gemm_phase<pg8::EpiProj, pg8::StaticOrder, true, true>(lds, g, S, E);
        if (BOTH(1)) GRID_BAR(); STAMP(2);
    }

    if (IN(2)) {
        attn_phase<0>(lds, PROJ, OG, LSE, args.in[6], args.in[7], vcu, G, tid, lane, wave);
        mlstmA_phase(lds, sm, PROJ, GATES, args.in[3], args.in[4], KVT, NCHK, SC, GS, KC, MIX, vcu, G, tid, lane, wave);
        if (BOTH(2)) GRID_BAR(); STAMP(3);
    }

#ifdef PROBE_P2
    if (IN(10)) attn_phase<0>(lds, PROJ, OG, LSE, args.in[6], args.in[7], vcu, G, tid, lane, wave);
    if (IN(12)) attn_phase<1>(lds, PROJ, OG, LSE, args.in[6], args.in[7], vcu, G, tid, lane, wave);
    if (IN(13)) attn_phase<2>(lds, PROJ, OG, LSE, args.in[6], args.in[7], vcu, G, tid, lane, wave);
    if (IN(11)) mlstmA_phase(lds, sm, PROJ, GATES, args.in[3], args.in[4], KVT, NCHK, SC, GS, KC, MIX, vcu, G, tid, lane, wave);
#endif
    if (IN(3)) { p3_scan_merge(KVT, NCHK, SC, CPT, NPREV, OG, LSE, MIX, vcu, G, tid); if (BOTH(3)) GRID_BAR(); STAMP(4); }

    if (IN(4)) {
        mlstmC_phase<0>(lds, sm, PROJ, GS, KC, CPT, NPREV, SC, args.in[8], MIX, vcu, G, tid, lane, wave);
        if (BOTH(4)) GRID_BAR(); STAMP(5);
    }

#ifdef PROBE_P4
    if (IN(15)) mlstmC_phase<1>(lds, sm, PROJ, GS, KC, CPT, NPREV, SC, args.in[8], MIX, vcu, G, tid, lane, wave);
    if (IN(16)) mlstmC_phase<2>(lds, sm, PROJ, GS, KC, CPT, NPREV, SC, args.in[8], MIX, vcu, G, tid, lane, wave);
#endif
    if (IN(5)) {
        pg8::Gemm g{MIX, WOUT, T, DM, DM}; pg8::StaticOrder S; S.init(T, DM, G, bx);
        pg8::EpiRes1 E{args.in[0], args.out, HB, ROWSS, DM};
        pg8::gemm_phase<pg8::EpiRes1, pg8::StaticOrder, false, true>(lds, g, S, E);
        if (BOTH(5)) GRID_BAR(); STAMP(6);
    }

    if (IN(6)) {
        pg8::Gemm g{HB, WGU, T, 2 * FF, DM}; pg8::StaticOrder S; S.init(T, 2 * FF, G, bx);
        pg8::EpiSwi E{HID, FF, ROWSS, EPS};
        pg8::gemm_phase<pg8::EpiSwi, pg8::StaticOrder, false, true>(lds, g, S, E);
        if (BOTH(6)) GRID_BAR(); STAMP(7);
    }

#ifdef PROBE_G
    if (IN(17)) { pg8::Gemm g{PROJ, PROJ + (size_t)T * DM, T, 2 * FF, DM}; pg8::StaticOrder S; S.init(T, 2 * FF, G, bx); pg8::EpiNone E{}; pg8::gemm_phase<pg8::EpiNone, pg8::StaticOrder, true, true>(lds, g, S, E); }
    if (IN(14)) { pg8::Gemm g{HB, WGU, T, 2 * FF, DM}; pg8::StaticOrder S; S.init(T, 2 * FF, G, bx); pg8::EpiNone E{}; pg8::gemm_phase<pg8::EpiNone, pg8::StaticOrder, true, true>(lds, g, S, E); }
#endif
    if (IN(7)) {
        pg8::Gemm g{HID, WDN, T, DM, FF}; pg8::StaticOrder S; S.init(T, DM, G, bx);
        pg8::EpiRes2 E{args.out, DM};
        pg8::gemm_phase<pg8::EpiRes2, pg8::StaticOrder, false, true>(lds, g, S, E);
    }
    STAMP(8);
#ifdef PROBE_T
    if (bx == 0 && tid == 0) { const unsigned dt = MISC[16 + PROBE_T + 1] - MISC[16 + PROBE_T]; const long long until = wall_clock64() + (long long)dt * 10;
        while (wall_clock64() < until) __builtin_amdgcn_s_sleep(8); }
#endif
#undef IN
#undef BOTH
}

extern "C" void kernel_launch(void* const* d_in, const int* in_sizes, int n_in, void* d_out, int out_size, void* d_ws, size_t ws_size, hipStream_t stream) {
    static int grid = 0;
    if (grid == 0) {
        if (n_in != 14 || in_sizes[0] != T * DM || out_size != T * DM || ws_size < WS_END) { fprintf(stderr, "kernel_launch: unexpected shapes (n_in %d, in0 %d, out %d, ws %zu); nothing launched\n", n_in, n_in > 0 ? in_sizes[0] : -1, out_size, ws_size); grid = -1; return; }
        int dev = 0, cus = 0, per_cu = 0;
        if (hipGetDevice(&dev) != hipSuccess || hipDeviceGetAttribute(&cus, hipDeviceAttributeMultiprocessorCount, dev) != hipSuccess) { fprintf(stderr, "kernel_launch: hipGetDevice / hipDeviceGetAttribute failed\n"); grid = -1; return; }
        if (hipFuncSetAttribute((const void*)hyb_fwd, hipFuncAttributeMaxDynamicSharedMemorySize, LDS_BYTES) != hipSuccess) { fprintf(stderr, "kernel_launch: hipFuncSetAttribute failed\n"); grid = -1; return; }
        if (hipOccupancyMaxActiveBlocksPerMultiprocessor(&per_cu, (const void*)hyb_fwd, NWAVES * 64, LDS_BYTES) != hipSuccess || per_cu < 1)
            fprintf(stderr, "kernel_launch: note: occupancy query reports %d workgroups per CU\n", per_cu);
        (void)hipGetLastError();
        grid = cus;
    }
    if (grid < 0) return;
    if (hipMemsetAsync((char*)d_ws + WS_CTL, 0, CTL_ZERO_BYTES, stream) != hipSuccess) { fprintf(stderr, "kernel_launch: hipMemsetAsync failed\n"); return; }
    Args a{};
    for (int i = 0; i < 14; ++i) a.in[i] = (const float*)d_in[i];
    a.out = (float*)d_out; a.ws = (unsigned char*)d_ws;
    static const int plist[] = PHASE_LIST;
    constexpr int NL = (int)(sizeof(plist) / sizeof(int)) / 2;
    static_assert(NL >= 1 && NL <= 16, "launch list");
    for (int li = 0; li < NL; ++li) {
        a.ph_lo = plist[2 * li]; a.ph_hi = plist[2 * li + 1]; a.li = li;
        hipLaunchKernelGGL(hyb_fwd, dim3(grid), dim3(NWAVES * 64), LDS_BYTES, stream, a);
        const hipError_t le = hipPeekAtLastError();
        if (le != hipSuccess) { fprintf(stderr, "kernel_launch: launch %d failed: %s\n", li, hipGetErrorName(le)); break; }
    }
}
```

```cpp
#include <hip/hip_runtime.h>
#include <cstdio>
#include <cstdint>
namespace pg8 {
#define PG8_LAS __attribute__((address_space(3)))
typedef unsigned short bf16_t;
typedef short bf16x8 __attribute__((ext_vector_type(8)));
typedef float f32x4 __attribute__((ext_vector_type(4)));
typedef unsigned u32x4 __attribute__((ext_vector_type(4)));
constexpr int BM = 256, BK = 64, HALF = 128, HTB = HALF * BK * 2  , STAGE_BYTES = 8 * HTB, NXCD = 8, WGM = 8;

__host__ __device__ __forceinline__ int lds_byte(int r, int c) { const int st = (r >> 4) * 2 + (c >> 5), rr = r & 15, cc = c & 31, ob = rr * 64 + cc * 2; return st * 1024 + (ob ^ (((ob >> 9) & 1) << 5)); }
__host__ __device__ __forceinline__ void stage_rc(int b, int& R, int& C) { const int st = b / 1024, sb = b % 1024, swz = sb ^ (((sb >> 9) & 1) << 5); R = (st >> 1) * 16 + swz / 64; C = (st & 1) * 32 + (swz % 64) / 2; }
__host__ __device__ __forceinline__ int perm32(int rho) { const int n = rho >> 4, i = rho & 15; return 8 * (i >> 2) + 4 * n + (i & 3); }

struct Unit { int pm, pn; };
struct Gemm { const bf16_t* A; const bf16_t* Bt; int M, N, K; };

struct StaticOrder {
    int nM, nN, nwg, G, c;
    __host__ __device__ void init(int M, int N, int G_, int c_) { nM = M / BM; nN = N / BM; nwg = nM * nN; G = G_; c = c_; }
    __host__ __device__ bool next(int i, Unit& u) const {
        const long L = (long)i * G + c; if (L >= nwg) return false;
        int wgid = (int)L; { const int q = nwg / NXCD, r = nwg % NXCD, xcd = wgid % NXCD, off = wgid / NXCD; wgid = (xcd < r ? xcd * (q + 1) : r * (q + 1) + (xcd - r) * q) + off; }
        const int nig = WGM * nN, gid = wgid / nig, fm = gid * WGM, gsz = (nM - fm) < WGM ? (nM - fm) : WGM;
        u.pm = fm + ((wgid % nig) % gsz); u.pn = (wgid % nig) / gsz; return true;
    }
    __device__ __forceinline__ void a_ready(const Unit&) const {}
    __device__ __forceinline__ void done(const Unit&) const {}
};
typedef float f32x2 __attribute__((ext_vector_type(2)));
typedef __bf16 bf16x2_t __attribute__((ext_vector_type(2)));
typedef unsigned u32x2 __attribute__((ext_vector_type(2)));
__device__ __forceinline__ unsigned cvt_pk_bf16(float lo, float hi) { f32x2 v = {lo, hi}; bf16x2_t b = __builtin_convertvector(v, bf16x2_t); return __builtin_bit_cast(unsigned, b); }

struct EpiProj {
    static constexpr bool PERM = true, AFTER_DRAIN = false;
    bf16_t* O; int ldc  ; const float* qg; const float* kg; PG8_LAS float* sm; float eps, qscale;
    __device__ __forceinline__ void operator()(const f32x4 (&acc)[2][2][4][2], const Unit& u, int wr, int wc, int fr, int fq) const {
        const int row0 = u.pm * BM + wr * 64 + fr, col0 = wc * 32 + 8 * fq;
        bf16_t* const slab = O + (size_t)(2 * u.pn) * ldc * HALF;
        if (u.pn < 8) {
            const float* gsrc = (u.pn < 4 ? qg : kg) + wc * 32 + 8 * fq; const float extra = u.pn < 4 ? qscale : 1.0f;
            const f32x4 ga = *(const f32x4*)gsrc, gb = *(const f32x4*)(gsrc + 4);
#pragma unroll
            for (int ai = 0; ai < 2; ++ai)
#pragma unroll
                for (int m = 0; m < 4; ++m)
#pragma unroll
                    for (int bj = 0; bj < 2; ++bj) { const f32x4 v0 = acc[ai][bj][m][0], v1 = acc[ai][bj][m][1];
                        float s = ((v0[0] * v0[0] + v0[1] * v0[1]) + (v0[2] * v0[2] + v0[3] * v0[3])) + ((v1[0] * v1[0] + v1[1] * v1[1]) + (v1[2] * v1[2] + v1[3] * v1[3]));
                        s += __shfl_xor(s, 16); s += __shfl_xor(s, 32);
                        if (fq == 0) sm[((ai * HALF + wr * 64 + m * 16 + fr) * 2 + bj) * 4 + wc] = s; }
            asm volatile("s_waitcnt lgkmcnt(0)" ::: "memory"); __builtin_amdgcn_s_barrier(); asm volatile("" ::: "memory");
#pragma unroll
            for (int ai = 0; ai < 2; ++ai)
#pragma unroll
                for (int m = 0; m < 4; ++m) { bf16_t* rowp = slab + (size_t)(row0 + ai * HALF + m * 16) * HALF + col0;
#pragma unroll
                    for (int bj = 0; bj < 2; ++bj) { const f32x4 pv = *(const PG8_LAS f32x4*)(sm + ((ai * HALF + wr * 64 + m * 16 + fr) * 2 + bj) * 4);
                        const float rs = __builtin_amdgcn_rsqf(((pv[0] + pv[1]) + (pv[2] + pv[3])) * (1.0f / 128.0f) + eps) * extra;
                        const f32x4 v0 = acc[ai][bj][m][0] * ga * rs, v1 = acc[ai][bj][m][1] * gb * rs;
                        u32x4 w; w.x = cvt_pk_bf16(v0[0], v0[1]); w.y = cvt_pk_bf16(v0[2], v0[3]); w.z = cvt_pk_bf16(v1[0], v1[1]); w.w = cvt_pk_bf16(v1[2], v1[3]);
                        *(u32x4*)(rowp + (size_t)bj * ldc * HALF) = w; } }
            asm volatile("s_waitcnt lgkmcnt(0)" ::: "memory"); __builtin_amdgcn_s_barrier(); asm volatile("" ::: "memory");
            return;
        }
#pragma unroll
        for (int ai = 0; ai < 2; ++ai)
#pragma unroll
            for (int m = 0; m < 4; ++m) { bf16_t* rowp = slab + (size_t)(row0 + ai * HALF + m * 16) * HALF + col0;
#pragma unroll
                for (int bj = 0; bj < 2; ++bj) { const f32x4 v0 = acc[ai][bj][m][0], v1 = acc[ai][bj][m][1];
                    u32x4 w; w.x = cvt_pk_bf16(v0[0], v0[1]); w.y = cvt_pk_bf16(v0[2], v0[3]); w.z = cvt_pk_bf16(v1[0], v1[1]); w.w = cvt_pk_bf16(v1[2], v1[3]);
                    *(u32x4*)(rowp + (size_t)bj * ldc * HALF) = w; } }
    }
};
struct EpiRes1 {
    static constexpr bool PERM = true, AFTER_DRAIN = false, INIT = false;
    const float* X; float* X1; bf16_t* X1B; float* rowss; int ldc;
    __device__ __forceinline__ void operator()(const f32x4 (&acc)[2][2][4][2], const Unit& u, int wr, int wc, int fr, int fq) const {
        const int row0 = u.pm * BM + wr * 64 + fr, col0 = u.pn * BM + wc * 32 + 8 * fq;
#pragma unroll
        for (int ai = 0; ai < 2; ++ai)
#pragma unroll
            for (int m = 0; m < 4; ++m) { const int r = row0 + ai * HALF + m * 16; const size_t off = (size_t)r * ldc + col0; float ss = 0.f;
#pragma unroll
                for (int bj = 0; bj < 2; ++bj) { const size_t c = off + bj * HALF;
                    const f32x4 v0 = *(const f32x4*)(X + c) + acc[ai][bj][m][0], v1 = *(const f32x4*)(X + c + 4) + acc[ai][bj][m][1];
                    *(f32x4*)(X1 + c) = v0; *(f32x4*)(X1 + c + 4) = v1;
                    ss += ((v0[0] * v0[0] + v0[1] * v0[1]) + (v0[2] * v0[2] + v0[3] * v0[3])) + ((v1[0] * v1[0] + v1[1] * v1[1]) + (v1[2] * v1[2] + v1[3] * v1[3]));
                    u32x4 w; w.x = cvt_pk_bf16(v0[0], v0[1]); w.y = cvt_pk_bf16(v0[2], v0[3]); w.z = cvt_pk_bf16(v1[0], v1[1]); w.w = cvt_pk_bf16(v1[2], v1[3]); *(u32x4*)(X1B + c) = w; }
                ss += __shfl_xor(ss, 16); ss += __shfl_xor(ss, 32);
                if (fq == 0) atomicAdd(rowss + r, ss);
                if (m == 3) asm volatile("" ::: "memory"); }
    }
};
struct EpiSwi {
    static constexpr bool PERM = true, AFTER_DRAIN = false;
    bf16_t* H; int ldc; const float* rowss; float eps;
    __device__ __forceinline__ void operator()(const f32x4 (&acc)[2][2][4][2], const Unit& u, int wr, int wc, int fr, int fq) const {
        const int row0 = u.pm * BM + wr * 64 + fr, col0 = u.pn * HALF + wc * 32 + 8 * fq;
        float rsv[2][4];
#pragma unroll
        for (int ai = 0; ai < 2; ++ai)
#pragma unroll
            for (int m = 0; m < 4; ++m) rsv[ai][m] = rowss[row0 + ai * HALF + m * 16];
#pragma unroll
        for (int ai = 0; ai < 2; ++ai)
#pragma unroll
            for (int m = 0; m < 4; ++m) { const int r = row0 + ai * HALF + m * 16; const float s = __builtin_amdgcn_rsqf(rsv[ai][m] * (1.0f / 2048.0f) + eps);
                float hv[8];
#pragma unroll
                for (int n = 0; n < 2; ++n)
#pragma unroll
                    for (int j = 0; j < 4; ++j) { const float g = acc[ai][0][m][n][j] * s, up = acc[ai][1][m][n][j] * s; hv[n * 4 + j] = g * __builtin_amdgcn_rcpf(1.0f + __expf(-g)) * up; }
                u32x4 w; w.x = cvt_pk_bf16(hv[0], hv[1]); w.y = cvt_pk_bf16(hv[2], hv[3]); w.z = cvt_pk_bf16(hv[4], hv[5]); w.w = cvt_pk_bf16(hv[6], hv[7]);
                *(u32x4*)(H + (size_t)r * ldc + col0) = w; }
    }
};
struct EpiNone {
    static constexpr bool PERM = true, AFTER_DRAIN = false;
    __device__ __forceinline__ void operator()(const f32x4 (&acc)[2][2][4][2], const Unit& u, int wr, int wc, int fr, int fq) const {
#pragma unroll
        for (int ai = 0; ai < 2; ++ai)
#pragma unroll
            for (int m = 0; m < 4; ++m)
#pragma unroll
                for (int bj = 0; bj < 2; ++bj) asm volatile("" :: "v"(acc[ai][bj][m][0]), "v"(acc[ai][bj][m][1]));
    }
};
struct EpiRes2 {
    static constexpr bool PERM = true, AFTER_DRAIN = false, INIT = false;
    float* OUT; int ldc;
    __device__ __forceinline__ void operator()(const f32x4 (&acc)[2][2][4][2], const Unit& u, int wr, int wc, int fr, int fq) const {
        const int row0 = u.pm * BM + wr * 64 + fr, col0 = u.pn * BM + wc * 32 + 8 * fq;
#pragma unroll
        for (int ai = 0; ai < 2; ++ai)
#pragma unroll
            for (int m = 0; m < 4; ++m) { float* rowp = OUT + (size_t)(row0 + ai * HALF + m * 16) * ldc + col0;
#pragma unroll
                for (int bj = 0; bj < 2; ++bj) { f32x4* p = (f32x4*)(rowp + bj * HALF); const f32x4 a = p[0] + acc[ai][bj][m][0], b = p[1] + acc[ai][bj][m][1]; p[0] = a; p[1] = b; }
                if (m == 3) asm volatile("" ::: "memory"); }
    }
};

template <class Epi, class Sched, bool ALIGN_EPI = false, bool SP2 = false>
__device__ __forceinline__ void gemm_phase(PG8_LAS unsigned char* lds, const Gemm g, const Sched& S, const Epi& E) {
    const int tid = threadIdx.x, wid = __builtin_amdgcn_readfirstlane(tid >> 6), lane = tid & 63, wr = wid >> 2, wc = wid & 3, fr = lane & 15, fq = lane >> 4;
    const int K = g.K, nt = K / BK;
    unsigned voffA[2], voffB[2];
#pragma unroll
    for (int i = 0; i < 2; ++i) { int R, C; stage_rc(tid * 16 + i * 8192, R, C); const int Rb = Epi::PERM ? ((R & ~31) + perm32(R & 31)) : R;
        voffA[i] = (unsigned)(R * K + C) * 2u; voffB[i] = (unsigned)(Rb * K + C) * 2u; }
    const size_t kstep = (size_t)(BK * 2);
    const size_t hstep = (size_t)HALF * K * 2;
    const size_t tstep = 2 * hstep;
    const unsigned ldsw = (unsigned)wid * 1024u;
    const int aoff = lds_byte(wr * 64 + fr, fq * 8), boff = lds_byte(wc * 32 + fr, fq * 8);
#define PG8_SA(b, h) (((b) * 2 + (h)) * HTB)
#define PG8_SB(b, h) ((4 + (b) * 2 + (h)) * HTB)
#define PG8_STAGE(bufoff, gbase, voff) do { _Pragma("unroll") for (int _i = 0; _i < 2; ++_i) \
        __builtin_amdgcn_global_load_lds((const unsigned*)((const char*)(gbase) + (voff)[_i]), (PG8_LAS unsigned*)(lds + (bufoff) + ldsw + _i * 8192), 16, 0, 0); } while (0)
#define PG8_LDA(dst, b, h) do { _Pragma("unroll") for (int m = 0; m < 4; ++m) _Pragma("unroll") for (int k = 0; k < 2; ++k) dst[m][k] = *(const PG8_LAS bf16x8*)(lds + PG8_SA(b, h) + aoff + m * 2048 + k * 1024); } while (0)
#define PG8_LDB(dst, b, h) do { _Pragma("unroll") for (int n = 0; n < 2; ++n) _Pragma("unroll") for (int k = 0; k < 2; ++k) dst[n][k] = *(const PG8_LAS bf16x8*)(lds + PG8_SB(b, h) + boff + n * 2048 + k * 1024); } while (0)
#define PG8_MMA(ai, bj, At, Bt) do { __builtin_amdgcn_s_setprio(1); _Pragma("unroll") for (int m = 0; m < 4; ++m) _Pragma("unroll") for (int n = 0; n < 2; ++n) _Pragma("unroll") for (int k = 0; k < 2; ++k) \
        acc[ai][bj][m][n] = __builtin_amdgcn_mfma_f32_16x16x32_bf16(Bt[n][k], At[m][k], acc[ai][bj][m][n], 0, 0, 0); __builtin_amdgcn_s_setprio(0); } while (0)
#define PG8_WAIT_V(n) asm volatile("s_waitcnt vmcnt(" #n ")" ::: "memory")
#define PG8_WAIT_L(n) asm volatile("s_waitcnt lgkmcnt(" #n ")" ::: "memory")
#define PG8_BAR __builtin_amdgcn_s_barrier()
#define PG8_SCHED __builtin_amdgcn_sched_barrier(0)
    Unit cur, nxt; int ui = 0;
    if (!S.next(0, cur)) return;
    f32x4 acc[2][2][4][2];
#pragma unroll
    for (int a = 0; a < 2; ++a)
#pragma unroll
        for (int b = 0; b < 2; ++b)
#pragma unroll
            for (int m = 0; m < 4; ++m)
#pragma unroll
                for (int n = 0; n < 2; ++n) acc[a][b][m][n] = (f32x4){0.f, 0.f, 0.f, 0.f};
    bf16x8 At[4][2], B0[2][2], B1[2][2];
    const char* cA = (const char*)g.A + (size_t)cur.pm * tstep; const char* cB = (const char*)g.Bt + (size_t)cur.pn * tstep;
    S.a_ready(cur);
    if constexpr (SP2) {
        PG8_STAGE(PG8_SB(0, 0), cB, voffB); PG8_STAGE(PG8_SB(0, 1), cB + hstep, voffB); PG8_STAGE(PG8_SA(0, 0), cA, voffA); PG8_STAGE(PG8_SA(0, 1), cA + hstep, voffA);
        if (wr == 1) PG8_BAR;
        PG8_WAIT_V(2); PG8_BAR;
        PG8_STAGE(PG8_SB(1, 0), cB + kstep, voffB); PG8_STAGE(PG8_SA(1, 0), cA + kstep, voffA); PG8_STAGE(PG8_SB(1, 1), cB + hstep + kstep, voffB);
        PG8_WAIT_V(6); PG8_BAR;
    } else {
        PG8_STAGE(PG8_SB(0, 0), cB, voffB); PG8_STAGE(PG8_SA(0, 0), cA, voffA); PG8_STAGE(PG8_SB(0, 1), cB + hstep, voffB); PG8_STAGE(PG8_SA(0, 1), cA + hstep, voffA);
        if (wr == 1) PG8_BAR;
        PG8_WAIT_V(4); PG8_BAR;
        PG8_STAGE(PG8_SB(1, 0), cB + kstep, voffB); PG8_STAGE(PG8_SA(1, 0), cA + kstep, voffA); PG8_STAGE(PG8_SB(1, 1), cB + hstep + kstep, voffB);
        PG8_WAIT_V(6); PG8_BAR;
    }
    for (;;) {
        const bool has_next = S.next(ui + 1, nxt);
        const char* nA = has_next ? (const char*)g.A + (size_t)nxt.pm * tstep : cA; const char* nB = has_next ? (const char*)g.Bt + (size_t)nxt.pn * tstep : cB;
        for (int t = 0; t < nt; t += 2) {
            const bool last = (t == nt - 2);
            const char* a1 = cA + (size_t)(t + 1) * kstep;
            const char* a2 = last ? nA : cA + (size_t)(t + 2) * kstep; const char* b2 = last ? nB : cB + (size_t)(t + 2) * kstep;
            const char* a3 = a2 + kstep; const char* b3 = b2 + kstep;
            if (last && has_next) S.a_ready(nxt);
            if constexpr (SP2) {
            PG8_LDB(B0, 0, 0); PG8_LDB(B1, 0, 1); PG8_SCHED; PG8_LDA(At, 0, 0); PG8_STAGE(PG8_SA(1, 1), a1 + hstep, voffA);
            PG8_WAIT_V(8); PG8_WAIT_L(0); PG8_BAR; PG8_MMA(0, 0, At, B0); PG8_MMA(0, 1, At, B1); PG8_BAR; PG8_SCHED;
            PG8_LDA(At, 0, 1); PG8_STAGE(PG8_SB(0, 0), b2, voffB); PG8_STAGE(PG8_SB(0, 1), b2 + hstep, voffB); PG8_STAGE(PG8_SA(0, 0), a2, voffA);
            PG8_WAIT_V(8); PG8_WAIT_L(0); PG8_BAR; PG8_MMA(1, 0, At, B0); PG8_MMA(1, 1, At, B1); PG8_BAR; PG8_SCHED;
            PG8_LDB(B0, 1, 0); PG8_LDB(B1, 1, 1); PG8_SCHED; PG8_LDA(At, 1, 0); PG8_STAGE(PG8_SA(0, 1), a2 + hstep, voffA);
            PG8_WAIT_V(8); PG8_WAIT_L(0); PG8_BAR; PG8_MMA(0, 0, At, B0); PG8_MMA(0, 1, At, B1); PG8_BAR; PG8_SCHED;
            PG8_LDA(At, 1, 1); PG8_STAGE(PG8_SB(1, 0), b3, voffB); PG8_STAGE(PG8_SB(1, 1), b3 + hstep, voffB); PG8_STAGE(PG8_SA(1, 0), a3, voffA);
            PG8_WAIT_V(8); PG8_WAIT_L(0); PG8_BAR; PG8_MMA(1, 0, At, B0); PG8_MMA(1, 1, At, B1); PG8_BAR; PG8_SCHED;
            } else {
            PG8_LDB(B0, 0, 0); PG8_SCHED; PG8_LDA(At, 0, 0); PG8_STAGE(PG8_SA(1, 1), a1 + hstep, voffA);
            PG8_WAIT_L(8); PG8_BAR; PG8_WAIT_L(0); PG8_MMA(0, 0, At, B0); PG8_BAR; PG8_SCHED;
            PG8_LDB(B1, 0, 1); PG8_STAGE(PG8_SB(0, 0), b2, voffB);
            PG8_BAR; PG8_WAIT_L(0); PG8_MMA(0, 1, At, B1); PG8_BAR;
            PG8_LDA(At, 0, 1); PG8_STAGE(PG8_SA(0, 0), a2, voffA);
            PG8_BAR; PG8_WAIT_L(0); PG8_MMA(1, 0, At, B0); PG8_BAR; PG8_SCHED;
            PG8_STAGE(PG8_SB(0, 1), b2 + hstep, voffB);
            PG8_WAIT_V(6); PG8_BAR; PG8_MMA(1, 1, At, B1); PG8_BAR;
            PG8_LDB(B0, 1, 0); PG8_SCHED; PG8_LDA(At, 1, 0); PG8_STAGE(PG8_SA(0, 1), a2 + hstep, voffA);
            PG8_WAIT_L(8); PG8_BAR; PG8_WAIT_L(0); PG8_MMA(0, 0, At, B0); PG8_BAR; PG8_SCHED;
            PG8_LDB(B1, 1, 1); PG8_STAGE(PG8_SB(1, 0), b3, voffB);
            PG8_BAR; PG8_WAIT_L(0); PG8_MMA(0, 1, At, B1); PG8_BAR;
            PG8_LDA(At, 1, 1); PG8_STAGE(PG8_SA(1, 0), a3, voffA);
            PG8_BAR; PG8_WAIT_L(0); PG8_MMA(1, 0, At, B0); PG8_BAR; PG8_SCHED;
            PG8_STAGE(PG8_SB(1, 1), b3 + hstep, voffB);
            PG8_WAIT_V(6); PG8_BAR; PG8_MMA(1, 1, At, B1); PG8_BAR;
            }
        }
        if constexpr (ALIGN_EPI) { if (wr == 0) PG8_BAR; }
        if constexpr (!Epi::AFTER_DRAIN) { E(acc, cur, wr, wc, fr, fq); S.done(cur); }
        if (!has_next) break;
#pragma unroll
        for (int a = 0; a < 2; ++a)
#pragma unroll
            for (int b = 0; b < 2; ++b)
#pragma unroll
                for (int m = 0; m < 4; ++m)
#pragma unroll
                    for (int n = 0; n < 2; ++n) acc[a][b][m][n] = (f32x4){0.f, 0.f, 0.f, 0.f};
        cur = nxt; cA = nA; cB = nB; ++ui;
        if constexpr (ALIGN_EPI) { if (wr == 1) PG8_BAR; }
    }
    PG8_WAIT_V(0);
    if constexpr (!ALIGN_EPI) { if (wr == 0) PG8_BAR; }
    PG8_BAR;
    if constexpr (Epi::AFTER_DRAIN) { E.fused(acc, cur, wr, wc, fr, fq, lds, wid, lane); S.done(cur); }
#undef PG8_SA
#undef PG8_SB
#undef PG8_STAGE
#undef PG8_LDA
#undef PG8_LDB
#undef PG8_MMA
#undef PG8_WAIT_V
#undef PG8_WAIT_L
#undef PG8_BAR
#undef PG8_SCHED
}
}

constexpr int NWAVES = 8;
#ifndef PHASE_LIST
#define PHASE_LIST {0, 8}
#endif
constexpr int N_PHASES = 8;

constexpr int BATCH = 4, SEQ = 4096, DM = 2048, HD = 128, NH = 8, AW = 1024, FF = 5632;
constexpr int T = BATCH * SEQ;
constexpr int INW = 7184, PJ = 7168;
constexpr int S_AQ = 0, S_AK = 1, S_AV = 2, S_MQ = 3, S_MK = 4, S_MV = 5, S_MO = 6;
constexpr int NCH = SEQ / 128;
constexpr float EPS = 1e-6f;
constexpr float LOG2E = 1.4426950408889634f, LN2 = 0.6931471805599453f;
constexpr float RSQRT_HD = 0.08838834764831845f;

constexpr size_t MiB = 1u << 20;
constexpr size_t WS_CTL = 0, CTL_ZERO_BYTES = 1 * MiB;
constexpr size_t WS_WIN = 1 * MiB;
constexpr size_t WS_WOUT = 29 * MiB;
constexpr size_t WS_WGU = 37 * MiB;
constexpr size_t WS_WDN = 81 * MiB;
constexpr size_t WS_HB = 104 * MiB;
constexpr size_t WS_PROJ = 168 * MiB;
constexpr size_t WS_MIX = 392 * MiB;
constexpr size_t WS_GATES = 456 * MiB;
constexpr size_t WS_LSE = 457 * MiB;
constexpr size_t WS_NCH = 459 * MiB;
constexpr size_t WS_NPREV = WS_NCH + 512 * 1024;
constexpr size_t WS_SC = 460 * MiB;
constexpr size_t WS_GS = 460 * MiB + 65536;
constexpr size_t WS_KC = 462 * MiB;
constexpr size_t WS_END = 494 * MiB;
constexpr size_t DO_ATT = 0, DO_CPT = 96 * MiB;
constexpr int CW_BAR = 4096;
constexpr int CW_ROWSS = 65536;
static_assert((CW_ROWSS + T) * 4 <= (int)CTL_ZERO_BYTES && CW_BAR + 16 * 3456 <= CW_ROWSS, "CTL words inside the memset region");

constexpr int RING_BYTES = 131072;
constexpr int SM_OFF = 135168;
constexpr int LDSCTL_OFF = 143360, MISC_OFF = LDSCTL_OFF + 320;
constexpr int LDS_BYTES = 147456;
static_assert(MISC_OFF + 128 <= LDS_BYTES, "LDS map");

#define GAS __attribute__((address_space(1)))
#define LAS __attribute__((address_space(3)))
typedef unsigned short bf16;
typedef unsigned v4u __attribute__((ext_vector_type(4)));
typedef unsigned v2u __attribute__((ext_vector_type(2)));
typedef float f32x4 __attribute__((ext_vector_type(4)));
typedef short bf16x8 __attribute__((ext_vector_type(8)));
typedef short s16x4 __attribute__((ext_vector_type(4)));
typedef GAS unsigned gu32;
#define RLX_AGENT __ATOMIC_RELAXED, __HIP_MEMORY_SCOPE_AGENT
#define LDS_WAIT() asm volatile("s_waitcnt lgkmcnt(0)" ::: "memory")
#define VM_WAIT() asm volatile("s_waitcnt vmcnt(0)" ::: "memory")
#define LBAR() do { asm volatile("s_waitcnt lgkmcnt(0)" ::: "memory"); __builtin_amdgcn_s_barrier(); asm volatile("" ::: "memory"); } while (0)
__device__ __forceinline__ unsigned pk2(float lo, float hi) { return pg8::cvt_pk_bf16(lo, hi); }
__device__ __forceinline__ float bf_lo(unsigned u) { return __uint_as_float(u << 16); }
__device__ __forceinline__ float bf_hi(unsigned u) { return __uint_as_float(u & 0xffff0000u); }
__device__ __forceinline__ void unpack8(const v4u r, float* f) { f[0] = bf_lo(r.x); f[1] = bf_hi(r.x); f[2] = bf_lo(r.y); f[3] = bf_hi(r.y); f[4] = bf_lo(r.z); f[5] = bf_hi(r.z); f[6] = bf_lo(r.w); f[7] = bf_hi(r.w); }
__device__ __forceinline__ v4u pack8(const float* f) { v4u r; r.x = pk2(f[0], f[1]); r.y = pk2(f[2], f[3]); r.z = pk2(f[4], f[5]); r.w = pk2(f[6], f[7]); return r; }
__device__ __forceinline__ f32x4 mfma16(bf16x8 a, bf16x8 b, f32x4 c) { return __builtin_amdgcn_mfma_f32_16x16x32_bf16(a, b, c, 0, 0, 0); }
__device__ __forceinline__ s16x4 tr_read(LAS unsigned char* p) { return __builtin_amdgcn_ds_read_tr16_b64_v4i16((LAS s16x4*)p); }
__device__ __forceinline__ bf16x8 cat44(s16x4 lo, s16x4 hi) { return __builtin_shufflevector(lo, hi, 0, 1, 2, 3, 4, 5, 6, 7); }
__device__ __forceinline__ float siluf(float y) { return y * __builtin_amdgcn_rcpf(1.0f + __expf(-y)); }
__device__ __forceinline__ float sigmf(float y) { return __builtin_amdgcn_rcpf(1.0f + __expf(-y)); }
__device__ __forceinline__ const bf16* seg_ptr(const bf16* proj, int seg, int h) { return proj + (size_t)(seg * NH + h) * T * HD; }
__device__ __forceinline__ int kimg(int r, int ch) { return r * 256 + ((ch ^ (r & 15)) << 4); }
__device__ __forceinline__ int vimg(int r, int ch) { return r * 256 + ((ch ^ ((r & 7) << 1)) << 4); }
#define XB_TMO      128
#define XB_XCNT(j)  (256  + 64 * (j))
#define XB_XSUB(j)  (1280 + 64 * (j))
#define XB_XGEN(j)  (2304 + 64 * (j))
#define XB_TOP      3328
#define XB_TOPGEN   3392
#define XCD_BAR_WORDS 3456
#define XB_SPIN_CAP (1u << 18)

__device__ __forceinline__ unsigned xb_ld(unsigned* p)              { return __hip_atomic_load(p, __ATOMIC_RELAXED, __HIP_MEMORY_SCOPE_AGENT); }
__device__ __forceinline__ unsigned xb_add(unsigned* p, unsigned v) { return __hip_atomic_fetch_add(p, v, __ATOMIC_RELAXED, __HIP_MEMORY_SCOPE_AGENT); }
__device__ __forceinline__ unsigned xb_xcc_id() { return (unsigned)__builtin_amdgcn_s_getreg((3 << 11) | 20) & 0xFu; }
#define XB_SPIN(cond, bar) do { unsigned _sp = 0; while (cond) { __builtin_amdgcn_s_sleep(1); \
    if ((++_sp & 255u) == 0u) { if (xb_ld(&(bar)[XB_TMO])) break; if (_sp > XB_SPIN_CAP) { atomicAdd(&(bar)[XB_TMO], 1u); break; } } } } while (0)

struct XcdBarrier {
    unsigned* bar; unsigned x;
    volatile LAS unsigned* st;
};

__device__ __forceinline__ XcdBarrier xcd_barrier_post(unsigned* bar, volatile LAS unsigned* st) {
    XcdBarrier b; b.bar = bar; b.x = xb_xcc_id(); b.st = st;
    if (threadIdx.x == 0) (void)xb_add(&bar[XB_XCNT(b.x)], 1u);
    return b;
}
__device__ __forceinline__ void xcd_barrier_complete(unsigned* bar, unsigned x, unsigned& nloc, unsigned& nx) {
    const unsigned G = gridDim.x * gridDim.y * gridDim.z;
    unsigned sum, cnt, mine, sp = 0u;
    for (;;) {
        sum = 0u; cnt = 0u; mine = 0u;
#pragma unroll
        for (unsigned j = 0; j < 16; ++j) { const unsigned c = xb_ld(&bar[XB_XCNT(j)]); sum += c; cnt += (c > 0u) ? 1u : 0u; mine = (j == x) ? c : mine; }
        if (sum == G) break;
        __builtin_amdgcn_s_sleep(1);
        if ((++sp & 255u) == 0u) { if (xb_ld(&bar[XB_TMO])) break; if (sp > XB_SPIN_CAP) { atomicAdd(&bar[XB_TMO], 1u); break; } }
    }
    nloc = mine > 0u ? mine : 1u; nx = cnt > 0u ? cnt : 1u;
}

__device__ __forceinline__ void xcd_barrier(const XcdBarrier& b) {
    asm volatile("s_waitcnt vmcnt(0)" ::: "memory");
    __syncthreads();
    if (threadIdx.x == 0) {
        unsigned* bar = b.bar;
        __builtin_amdgcn_s_waitcnt(0);
        unsigned nloc = b.st[0], nx = b.st[1];
        if (nloc == 0u) { xcd_barrier_complete(bar, b.x, nloc, nx); b.st[0] = nloc; b.st[1] = nx; }
        const unsigned old = xb_add(&bar[XB_XSUB(b.x)], 1u);
        const unsigned gen = old / nloc;
        if (old + 1u == (gen + 1u) * nloc) {
            __builtin_amdgcn_fence(__ATOMIC_RELEASE, "agent");
            asm volatile("s_waitcnt vmcnt(0)" ::: "memory");
            const unsigned og = xb_add(&bar[XB_TOP], 1u);
            const unsigned tg = og / nx;
            if (og + 1u == (tg + 1u) * nx) xb_add(&bar[XB_TOPGEN], 1u);
            else XB_SPIN(xb_ld(&bar[XB_TOPGEN]) == tg, bar);
            __builtin_amdgcn_fence(__ATOMIC_ACQUIRE, "agent");
            xb_add(&bar[XB_XGEN(b.x)], 1u);
            asm volatile("s_waitcnt vmcnt(0)" ::: "memory");
        } else {
            XB_SPIN(xb_ld(&bar[XB_XGEN(b.x)]) == gen, bar);
            __builtin_amdgcn_fence(__ATOMIC_ACQUIRE, "agent");
            asm volatile("s_waitcnt vmcnt(0)" ::: "memory");
        }
    }
    __syncthreads();
}

__device__ __forceinline__ float wave_sum(float v) {
#pragma unroll
    for (int o = 1; o < 64; o <<= 1) v += __shfl_xor(v, o);
    return v;
}
struct TItem { const float* W; const float* ksc; bf16* WT; int ldw, K, mode, k0, n0; };
__device__ __forceinline__ void p0_load(const TItem& t, f32x4 (&v)[8], int lane) {
    const float* p = t.W + (size_t)(t.k0 + (lane >> 3)) * t.ldw + t.n0 + 4 * (lane & 7);
#pragma unroll
    for (int i = 0; i < 8; ++i) v[i] = *(const f32x4*)(p + (size_t)(8 * i) * t.ldw);
}
__device__ __forceinline__ void p0_emit(const TItem& t, const f32x4 (&v)[8], LAS float* scr, int lane) {
#pragma unroll
    for (int i = 0; i < 8; ++i) { const int kk = 8 * i + (lane >> 3); f32x4 y = v[i]; if (t.ksc) y = y * t.ksc[t.k0 + kk];
        LAS float* d = scr + kk * 33 + 4 * (lane & 7); d[0] = y.x; d[1] = y.y; d[2] = y.z; d[3] = y.w; }
    LDS_WAIT(); asm volatile("" ::: "memory");
    const int c = lane & 7;
    int nbase = t.n0; if (t.mode) nbase = ((t.n0 >> 7) << 8) + (t.n0 & 127) + (t.mode == 2 ? 128 : 0);
#pragma unroll
    for (int j = 0; j < 4; ++j) { const int n = (lane >> 3) + 8 * j; const LAS float* s = scr + (8 * c) * 33 + n;
        v4u o; o.x = pk2(s[0 * 33], s[1 * 33]); o.y = pk2(s[2 * 33], s[3 * 33]); o.z = pk2(s[4 * 33], s[5 * 33]); o.w = pk2(s[6 * 33], s[7 * 33]);
        *(GAS v4u*)(t.WT + (size_t)(nbase + n) * t.K + t.k0 + 8 * c) = o; }
    LDS_WAIT(); asm volatile("" ::: "memory");
}
constexpr int P0_SCR = 8448, P0_WG = 69632;
__device__ __forceinline__ int wgimg(int gate, int c) { return P0_WG + gate * 4096 + ((c ^ gate) << 4); }
template <int PARTS> __device__ __forceinline__ void p0_prologue(LAS unsigned char* lds, LAS float* sm, const float* const* in, unsigned char* ws, int vcu, int G, int tid, int lane, int wave) {
    const float* w_in = in[2]; const float* w_out = in[9]; const float* nfg = in[10]; const float* w_gate = in[11]; const float* w_up = in[12]; const float* w_down = in[13];
    {   float f[8][8];
#pragma unroll
        for (int i = 0; i < 8; ++i) { const int pr = tid + i * NWAVES * 64, gate = pr & 15, c = pr >> 4;
#pragma unroll
            for (int j = 0; j < 8; ++j) f[i][j] = w_in[(size_t)(8 * c + j) * INW + PJ + gate]; }
#pragma unroll
        for (int i = 0; i < 8; ++i) { const int pr = tid + i * NWAVES * 64, gate = pr & 15, c = pr >> 4; *(LAS v4u*)(lds + wgimg(gate, c)) = pack8(f[i]); }
    }
    LAS float* scr = (LAS float*)(lds + wave * P0_SCR);
    const int gw = vcu * NWAVES + wave, NGW = G * NWAVES;
    bf16* WIN = (bf16*)(ws + WS_WIN); bf16* WOUT = (bf16*)(ws + WS_WOUT); bf16* WGU = (bf16*)(ws + WS_WGU); bf16* WDN = (bf16*)(ws + WS_WDN);
    constexpr int I_IN = (DM / 64) * (PJ / 32), I_OUT = (DM / 64) * (DM / 32), I_G = (DM / 64) * (FF / 32), I_D = (FF / 64) * (DM / 32);
    constexpr int NITEMS = I_IN + I_OUT + 2 * I_G + I_D;
    auto decode = [&](int it) -> TItem {
        TItem t; int r = it, nblk;
        if (r < I_IN) { t.W = w_in; t.ldw = INW; nblk = PJ / 32; t.K = DM; t.WT = WIN; t.ksc = nullptr; t.mode = 0; }
        else if ((r -= I_IN) < I_OUT) { t.W = w_out; t.ldw = DM; nblk = DM / 32; t.K = DM; t.WT = WOUT; t.ksc = nullptr; t.mode = 0; }
        else if ((r -= I_OUT) < I_G) { t.W = w_gate; t.ldw = FF; nblk = FF / 32; t.K = DM; t.WT = WGU; t.ksc = nfg; t.mode = 1; }
        else if ((r -= I_G) < I_G) { t.W = w_up; t.ldw = FF; nblk = FF / 32; t.K = DM; t.WT = WGU; t.ksc = nfg; t.mode = 2; }
        else { r -= I_G; t.W = w_down; t.ldw = DM; nblk = DM / 32; t.K = FF; t.WT = WDN; t.ksc = nullptr; t.mode = 0; }
        const int kb = r / nblk; t.k0 = 64 * kb; t.n0 = 32 * (r - kb * nblk); return t; };
    if (PARTS & 1) {
        int it = gw; f32x4 va[8], vb[8]; TItem ta, tb;
        if (it < NITEMS) { ta = decode(it); p0_load(ta, va, lane); }
        while (it < NITEMS) {
            int itn = it + NGW; if (itn < NITEMS) { tb = decode(itn); p0_load(tb, vb, lane); }
            p0_emit(ta, va, scr, lane);
            it = itn; if (it >= NITEMS) break;
            itn = it + NGW; if (itn < NITEMS) { ta = decode(itn); p0_load(ta, va, lane); }
            p0_emit(tb, vb, scr, lane);
            it = itn;
        }
    }
    const float* x = in[0]; const float* nmg = in[1]; const float* gate_b = in[5];
    bf16* HB = (bf16*)(ws + WS_HB); float* GATES = (float*)(ws + WS_GATES);
    f32x4 gn[8];
#pragma unroll
    for (int j = 0; j < 8; ++j) gn[j] = *((const f32x4*)nmg + lane + 64 * j);
    if (PARTS & 2) for (int rg = vcu; rg < T / 64; rg += G) {
        const int m0 = rg * 64 + 8 * wave;
        f32x4 nv[8];
        { const GAS f32x4* xr = (const GAS f32x4*)(x + (size_t)m0 * DM) + lane;
#pragma unroll
          for (int j = 0; j < 8; ++j) nv[j] = xr[64 * j]; }
#pragma unroll 1
        for (int i = 0; i < 8; ++i) {
            f32x4 v[8]; float s = 0.f;
#pragma unroll
            for (int j = 0; j < 8; ++j) { v[j] = nv[j]; s += (v[j].x * v[j].x + v[j].y * v[j].y) + (v[j].z * v[j].z + v[j].w * v[j].w); }
            if (i < 7) { const GAS f32x4* xr = (const GAS f32x4*)(x + (size_t)(m0 + i + 1) * DM) + lane;
#pragma unroll
                for (int j = 0; j < 8; ++j) nv[j] = xr[64 * j]; }
            const float rstd = 1.0f / sqrtf(wave_sum(s) * (1.f / DM) + EPS);
            GAS unsigned long long* o8 = (GAS unsigned long long*)(HB + (size_t)(m0 + i) * DM) + lane;
#pragma unroll
            for (int j = 0; j < 8; ++j) { const f32x4 y = v[j] * rstd * gn[j]; o8[64 * j] = (unsigned long long)pk2(y.x, y.y) | ((unsigned long long)pk2(y.z, y.w) << 32); }
        }
        VM_WAIT(); __syncthreads();
        {
            const int x16 = lane & 15, g = lane >> 4, q = wave >> 1, kh = wave & 1;
            const bf16* hp = HB + (size_t)(rg * 64 + 16 * q + x16) * DM + 1024 * kh + 8 * g;
            f32x4 acc = (f32x4){0.f, 0.f, 0.f, 0.f};
#pragma unroll 8
            for (int s = 0; s < 32; ++s) {
                const bf16x8 bq = __builtin_bit_cast(bf16x8, *(const v4u*)(hp + 32 * s));
                const bf16x8 a = *(const LAS bf16x8*)(lds + wgimg(x16, 128 * kh + 4 * s + g));
                acc = mfma16(a, bq, acc);
            }
            if (kh) *(LAS f32x4*)(sm + (q * 64 + lane) * 4) = acc;
            __syncthreads();
            if (!kh) { const f32x4 o = *(const LAS f32x4*)(sm + (q * 64 + lane) * 4); const f32x4 gb = *(const f32x4*)(gate_b + 4 * g);
                *(f32x4*)(GATES + (size_t)(rg * 64 + 16 * q + x16) * 16 + 4 * g) = acc + o + gb; }
            __syncthreads();
        }
    }
}

struct AttnP { int b, h, dil, gi, r, n; };
__device__ __forceinline__ AttnP attn_decode(int L) {
    const int xc = (L & 255) >> 5, jj = L & 31, ii = L >> 8, qx = jj + 32 * ii;
    const int bh = 4 * xc + qx / 96, rem = qx % 96, gi = rem >> 5, i32 = rem & 31, sh = 2 * gi;
    AttnP p; p.gi = gi; p.dil = 1 << sh; p.b = bh >> 3; p.h = bh & 7; p.r = i32 & (p.dil - 1); p.n = i32 >> sh; return p;
}
__device__ __forceinline__ void attn_prefetch_k(const bf16* proj, const AttnP& p, int tid, v4u (&kr)[8]) {
    const unsigned vo = (unsigned)((tid >> 4) * p.dil * HD + (tid & 15) * 8) * 2u;
#pragma unroll
    for (int it = 0; it < 8; ++it) {
        const int ci = 128 * (p.n - 1) + it * 32 + ((p.n == 0 && it < 4) ? 128 : 0);
        const char* sb = (const char*)(seg_ptr(proj, S_AK, p.h) + ((size_t)p.b * SEQ + (size_t)ci * p.dil + p.r) * HD);
        kr[it] = *(const v4u*)(sb + vo);
    }
}
__device__ __forceinline__ void attn_load_q(const bf16* proj, const AttnP& p, int lane, int w, v4u (&qr)[4]) {
    const char* qb = (const char*)(seg_ptr(proj, S_AQ, p.h) + ((size_t)p.b * SEQ + (size_t)(128 * p.n + 16 * w) * p.dil + p.r) * HD);
    const unsigned qo = (unsigned)((lane & 15) * p.dil * HD + 8 * (lane >> 4)) * 2u;
#pragma unroll
    for (int s = 0; s < 4; ++s) qr[s] = *(const v4u*)(qb + qo + 64 * s);
}
__device__ __forceinline__ void attn_prefetch_v(const bf16* proj, const AttnP& p, int tid, v4u (&vr)[8]) {
    const unsigned vo = (unsigned)((tid >> 4) * p.dil * HD + (tid & 15) * 8) * 2u;
#pragma unroll
    for (int it = 0; it < 8; ++it) {
        const int ci = 128 * (p.n - 1) + it * 32 + ((p.n == 0 && it < 4) ? 128 : 0);
        const char* sb = (const char*)(seg_ptr(proj, S_AV, p.h) + ((size_t)p.b * SEQ + (size_t)ci * p.dil + p.r) * HD);
        vr[it] = *(const v4u*)(sb + vo);
    }
}
__device__ __forceinline__ void attn_stage(LAS unsigned char* lds, const AttnP& p, int tid, const v4u (&kr)[8], const v4u (&vr)[8], const v4u (&qr)[4], bf16x8 (&qf)[4]) {
    const int ch = tid & 15;
#pragma unroll
    for (int it = 0; it < 8; ++it) {
        const int row = it * 32 + (tid >> 4); const bool ok = (128 * (p.n - 1) + row) >= 0;
        v4u ko = kr[it], vo = vr[it];
        if (!ok) { ko = (v4u){0u, 0u, 0u, 0u}; vo = (v4u){0u, 0u, 0u, 0u}; }
        *(LAS v4u*)(lds + kimg(row, ch)) = ko;
        *(LAS v4u*)(lds + 65536 + vimg(row, ch)) = vo;
    }
#pragma unroll
    for (int s = 0; s < 4; ++s) qf[s] = __builtin_bit_cast(bf16x8, qr[s]);
}
template <bool FIRST, int MODE = 0> __device__ __forceinline__ void attn_compute(LAS unsigned char* lds, const AttnP& p, const bf16x8 (&qf)[4], float cb, bf16* og, float* osum, int lane, int w) {
    const int x = lane & 15, g = lane >> 4, n = p.n, q4 = x >> 2, p2 = x & 3;
    const size_t tq = (size_t)p.b * SEQ + (size_t)(128 * n + 16 * w + x) * p.dil + p.r;
    const int start = w < 6 ? w : 6;
    int kbase[4], vbase[8];
#pragma unroll
    for (int s = 0; s < 4; ++s) kbase[s] = (start * 16 + x) * 256 + (((4 * s + g) ^ x) << 4);
#pragma unroll
    for (int eb = 0; eb < 8; ++eb) vbase[eb] = 65536 + (start * 16 + 4 * g + q4) * 256 + (((2 * eb + (p2 >> 1)) ^ (((4 * g + q4) & 7) << 1)) << 4) + 8 * (p2 & 1);
    f32x4 oacc[8];
#pragma unroll
    for (int eb = 0; eb < 8; ++eb) oacc[eb] = (f32x4){0.f, 0.f, 0.f, 0.f};
    const int qrel = 16 * w + x; float sum = 0.f;
    bf16x8 ka[2][4];
#pragma unroll
    for (int h2 = 0; h2 < 2; ++h2)
#pragma unroll
        for (int s = 0; s < 4; ++s) ka[h2][s] = *(const LAS bf16x8*)(lds + kbase[s] + h2 * 4096);
#pragma unroll
    for (int i = 0; i < 5; ++i) {
        s16x4 va[8][2];
#pragma unroll
        for (int eb = 0; eb < 8; ++eb) { va[eb][0] = tr_read(lds + vbase[eb] + i * 8192); va[eb][1] = tr_read(lds + vbase[eb] + i * 8192 + 4096); }
        f32x4 sc[2];
#pragma unroll
        for (int h2 = 0; h2 < 2; ++h2) { sc[h2] = (f32x4){0.f, 0.f, 0.f, 0.f};
#pragma unroll
            for (int s = 0; s < 4; ++s) sc[h2] = mfma16(ka[h2][s], qf[s], sc[h2]); }
        if (i < 4) {
#pragma unroll
            for (int h2 = 0; h2 < 2; ++h2)
#pragma unroll
                for (int s = 0; s < 4; ++s) ka[h2][s] = *(const LAS bf16x8*)(lds + kbase[s] + (2 * i + 2 + h2) * 4096);
        }
        float pe[2][4];
#pragma unroll
        for (int h2 = 0; h2 < 2; ++h2)
#pragma unroll
            for (int q = 0; q < 4; ++q) {
                float e = __builtin_amdgcn_exp2f(sc[h2][q] - cb);
                if (FIRST || i == 0 || i == 4) { const int kr = (start + 2 * i + h2) * 16 + 4 * g + q - 128, dist = qrel - kr; const bool valid = (dist >= 0) && (dist <= 128) && (!FIRST || kr >= 0); e = valid ? e : 0.f; }
                pe[h2][q] = e; sum += e; }
        v4u pw; pw.x = pk2(pe[0][0], pe[0][1]); pw.y = pk2(pe[0][2], pe[0][3]); pw.z = pk2(pe[1][0], pe[1][1]); pw.w = pk2(pe[1][2], pe[1][3]);
        const bf16x8 pf = __builtin_bit_cast(bf16x8, pw);
#pragma unroll
        for (int eb = 0; eb < 8; ++eb) oacc[eb] = mfma16(cat44(va[eb][0], va[eb][1]), pf, oacc[eb]);
    }
    sum += __shfl_xor(sum, 16); sum += __shfl_xor(sum, 32);
    const float inv = 1.0f / sum;
    bf16* op = og + ((size_t)(p.gi * NH + p.h) * T + tq) * HD + 4 * g;
#pragma unroll
    for (int eb = 0; eb < 8; ++eb) { v2u o; o.x = pk2(oacc[eb][0] * inv, oacc[eb][1] * inv); o.y = pk2(oacc[eb][2] * inv, oacc[eb][3] * inv); if (MODE == 0) *(v2u*)(op + 16 * eb) = o; else asm volatile("" :: "v"(o.x), "v"(o.y)); }
    if (MODE == 0) { if (g == 0) osum[(size_t)(p.gi * NH + p.h) * T + tq] = sum; }
}
template <int MODE = 0> __device__ __forceinline__ void attn_phase(LAS unsigned char* lds, const bf16* proj, bf16* og, float* osum, const float* __restrict__ qg, const float* __restrict__ kg, int vcu, int G, int tid, int lane, int w) {
    int L = vcu; if (L >= 3072) return;
    float cb;
    { float mq = fmaxf(fabsf(qg[lane]), fabsf(qg[lane + 64])), mk = fmaxf(fabsf(kg[lane]), fabsf(kg[lane + 64]));
#pragma unroll
      for (int o = 32; o >= 1; o >>= 1) { mq = fmaxf(mq, __shfl_xor(mq, o)); mk = fmaxf(mk, __shfl_xor(mk, o)); }
      cb = 11.313708499f * mq * mk * LOG2E; }
    AttnP p = attn_decode(L);
    v4u kr[8], vr[8], qr[4];
    attn_prefetch_k(proj, p, tid, kr); attn_prefetch_v(proj, p, tid, vr); attn_load_q(proj, p, lane, w, qr);
    for (;;) {
        bf16x8 qf[4];
        attn_stage(lds, p, tid, kr, vr, qr, qf);
        LBAR();
        const int Ln = L + G; const bool more = Ln < 3072;
        const AttnP pn = attn_decode(more ? Ln : L);
        if (MODE != 2) { attn_prefetch_k(proj, pn, tid, kr); attn_prefetch_v(proj, pn, tid, vr); attn_load_q(proj, pn, lane, w, qr); }
        if (MODE != 1) { if (p.n == 0) attn_compute<true, MODE>(lds, p, qf, cb, og, osum, lane, w); else attn_compute<false, MODE>(lds, p, qf, cb, og, osum, lane, w); }
        LBAR();
        if (!more) break;
        p = pn; L = Ln;
    }
}

__device__ __forceinline__ void gate_prepass(const float* gates, float* gs, float* sc, int idx, int lane) {
    const int c = idx & 31, bh = idx >> 5, h = bh & 7, b = bh >> 3;
    const size_t t0 = (size_t)b * SEQ + 128 * c;
    const float* g0 = gates + (t0 + lane) * 16, * g1 = gates + (t0 + 64 + lane) * 16;
    const float i0 = g0[h], f0 = g0[8 + h], i1 = g1[h], f1 = g1[8 + h];
    float v0 = fminf(f0, 0.f) - log1pf(expf(-fabsf(f0))), v1 = fminf(f1, 0.f) - log1pf(expf(-fabsf(f1)));
#pragma unroll
    for (int o = 1; o < 64; o <<= 1) { const float a0 = __shfl_up(v0, o), a1 = __shfl_up(v1, o); if (lane >= o) { v0 += a0; v1 += a1; } }
    v1 += __shfl(v0, 63);
    const float u0 = i0 - v0, u1 = i1 - v1;
    float m = fmaxf(u0, u1);
#pragma unroll
    for (int o = 32; o >= 1; o >>= 1) m = fmaxf(m, __shfl_xor(m, o));
    float* gp = gs + (size_t)idx * 256;
    gp[lane] = v0; gp[64 + lane] = v1; gp[128 + lane] = u0; gp[192 + lane] = u1;
    if (lane == 63) { sc[idx] = v1; sc[1024 + idx] = v1 + m; sc[3072 + idx] = m; }
}
__device__ __forceinline__ void load_conv_w(const float* __restrict__ convw, const float* __restrict__ convb, int cc, float (&cw)[4][8], float (&cb)[8]) {
#pragma unroll
    for (int tap = 0; tap < 4; ++tap) { const f32x4 a = *(const f32x4*)(convw + tap * 2048 + cc), c = *(const f32x4*)(convw + tap * 2048 + cc + 4);
        cw[tap][0] = a.x; cw[tap][1] = a.y; cw[tap][2] = a.z; cw[tap][3] = a.w; cw[tap][4] = c.x; cw[tap][5] = c.y; cw[tap][6] = c.z; cw[tap][7] = c.w; }
    const f32x4 a = *(const f32x4*)(convb + cc), c = *(const f32x4*)(convb + cc + 4);
    cb[0] = a.x; cb[1] = a.y; cb[2] = a.z; cb[3] = a.w; cb[4] = c.x; cb[5] = c.y; cb[6] = c.z; cb[7] = c.w;
}
__device__ __forceinline__ void stage_conv_w(LAS float* sm, const float* __restrict__ convw, const float* __restrict__ convb, int h, int tid) {
    for (int i = tid; i < 1280; i += NWAVES * 64) { const int path = i / 640, r = i - path * 640, tap = r >> 7, d = r & 127, cc = (path == 0 ? 1024 : 0) + h * 128 + d;
        sm[i] = tap < 4 ? convw[tap * 2048 + cc] : convb[cc]; }
}
__device__ __forceinline__ void load_conv_w_lds(const LAS float* sm, int path, int ch, float (&cw)[4][8], float (&cb)[8]) {
#pragma unroll
    for (int tap = 0; tap < 4; ++tap) { const f32x4 a = *(const LAS f32x4*)(sm + path * 640 + tap * 128 + ch * 8), c = *(const LAS f32x4*)(sm + path * 640 + tap * 128 + ch * 8 + 4);
        cw[tap][0] = a.x; cw[tap][1] = a.y; cw[tap][2] = a.z; cw[tap][3] = a.w; cw[tap][4] = c.x; cw[tap][5] = c.y; cw[tap][6] = c.z; cw[tap][7] = c.w; }
    const f32x4 a = *(const LAS f32x4*)(sm + path * 640 + 512 + ch * 8), c = *(const LAS f32x4*)(sm + path * 640 + 512 + ch * 8 + 4);
    cb[0] = a.x; cb[1] = a.y; cb[2] = a.z; cb[3] = a.w; cb[4] = c.x; cb[5] = c.y; cb[6] = c.z; cb[7] = c.w;
}
__device__ __forceinline__ void conv4x8(const v4u (&raw)[7], const float (&cw)[4][8], const float (&cb)[8], float (&y)[4][8]) {
#pragma unroll
    for (int i = 0; i < 4; ++i)
#pragma unroll
        for (int j = 0; j < 8; ++j) y[i][j] = cb[j];
#pragma unroll
    for (int r = 0; r < 7; ++r) { float f[8]; unpack8(raw[r], f);
#pragma unroll
        for (int i = 0; i < 4; ++i) { const int tap = r - i; if (tap >= 0 && tap < 4) {
#pragma unroll
            for (int j = 0; j < 8; ++j) y[i][j] += f[j] * cw[tap][j]; } } }
#pragma unroll
    for (int i = 0; i < 4; ++i)
#pragma unroll
        for (int j = 0; j < 8; ++j) y[i][j] = siluf(y[i][j]);
}

struct MARegs { v4u kraw[7], qraw[7], vr[4]; f32x4 u4; float umax; };
__device__ __forceinline__ void mA_prefetch(const bf16* proj, const float* gs, const float* sc, int idx, int tid, MARegs& R) {
    const int c = idx & 31, bh = idx >> 5, h = bh & 7, b = bh >> 3, rg = tid >> 4, ch = tid & 15;
    const size_t t0 = (size_t)b * SEQ + 128 * c;
    const bf16* bk3 = seg_ptr(proj, S_MK, h) + (t0 - 3) * HD, * bq3 = seg_ptr(proj, S_MQ, h) + (t0 - 3) * HD, * bv = seg_ptr(proj, S_MV, h) + t0 * HD;
    const int lo = (c == 0) ? 3 : 0;
#pragma unroll
    for (int j = 0; j < 7; ++j) { int row3 = 4 * rg + j; row3 = row3 < lo ? lo : row3;
        const unsigned vo = (unsigned)(row3 * HD + ch * 8) * 2u;
        R.kraw[j] = *(const v4u*)((const char*)bk3 + vo); R.qraw[j] = *(const v4u*)((const char*)bq3 + vo); }
    const unsigned vo = (unsigned)(4 * rg * HD + ch * 8) * 2u;
#pragma unroll
    for (int i = 0; i < 4; ++i) R.vr[i] = *(const v4u*)((const char*)(bv + i * HD) + vo);
    R.u4 = *(const f32x4*)(gs + (size_t)idx * 256 + 128 + 4 * rg);
    R.umax = __hip_atomic_load(sc + 3072 + idx, __ATOMIC_RELAXED, __HIP_MEMORY_SCOPE_AGENT);
}
__device__ __forceinline__ void mlstmA_phase(LAS unsigned char* lds, LAS float* sm, const bf16* proj, const float* gates, const float* __restrict__ convw, const float* __restrict__ convb,
                                             bf16* kvt, float* nch, float* sc, float* gs, bf16* kc, bf16* mix, int vcu, int G, int tid, int lane, int w) {
    if (vcu >= 1024) return;
    for (int idx = vcu + G * w; idx < 1024; idx += G * NWAVES) gate_prepass(gates, gs, sc, idx, lane);
    int hcur = (vcu >> 5) & 7; stage_conv_w(sm, convw, convb, hcur, tid);
    VM_WAIT(); __syncthreads();
    int idx = vcu;
    MARegs R; mA_prefetch(proj, gs, sc, idx, tid, R);
    const int x = lane & 15, g = lane >> 4, rg = tid >> 4, ch = tid & 15;
    for (;;) {
        const int c = idx & 31, bh = idx >> 5, h = bh & 7, b = bh >> 3;
        const size_t t0 = (size_t)b * SEQ + 128 * c;
        if (h != hcur) { hcur = h; stage_conv_w(sm, convw, convb, hcur, tid); VM_WAIT(); LBAR(); }
        if (c == 0 && rg == 0) {
#pragma unroll
            for (int j = 0; j < 3; ++j) { R.kraw[j] = (v4u){0u, 0u, 0u, 0u}; R.qraw[j] = (v4u){0u, 0u, 0u, 0u}; } }
        {
            float cw[4][8], cb[8]; load_conv_w_lds(sm, 0, ch, cw, cb);
            float y[4][8]; conv4x8(R.kraw, cw, cb, y);
#pragma unroll
            for (int i = 0; i < 4; ++i) { const int l = 4 * rg + i; const float wa = __expf(R.u4[i] - R.umax);
#pragma unroll
                for (int j = 0; j < 8; ++j) y[i][j] *= RSQRT_HD;
                *(v4u*)(kc + ((size_t)h * T + t0 + l) * HD + ch * 8) = pack8(y[i]);
#pragma unroll
                for (int j = 0; j < 8; ++j) y[i][j] *= wa;
                *(LAS v4u*)(lds + vimg(l, ch)) = pack8(y[i]); }
        }
        {
            float cw[4][8], cb[8]; load_conv_w_lds(sm, 1, ch, cw, cb);
            float y[4][8]; conv4x8(R.qraw, cw, cb, y);
#pragma unroll
            for (int i = 0; i < 4; ++i) *(v4u*)(mix + (t0 + 4 * rg + i) * DM + AW + h * 128 + ch * 8) = pack8(y[i]);
        }
#pragma unroll
        for (int i = 0; i < 4; ++i) *(LAS v4u*)(lds + 32768 + vimg(4 * rg + i, ch)) = R.vr[i];
        LBAR();
        const int idn = idx + G; const bool more = idn < 1024;
        mA_prefetch(proj, gs, sc, more ? idn : idx, tid, R);
        f32x4 acc[8], accn = (f32x4){0.f, 0.f, 0.f, 0.f};
#pragma unroll
        for (int db = 0; db < 8; ++db) acc[db] = (f32x4){0.f, 0.f, 0.f, 0.f};
        const int q4 = x >> 2, p2 = x & 3;
        const int xr = ((4 * g + q4) & 7) << 1;
        const int rowb = (4 * g + q4) * 256 + 8 * (p2 & 1);
        int vbase = 32768 + rowb + (((2 * w + (p2 >> 1)) ^ xr) << 4), kb[8];
#pragma unroll
        for (int db = 0; db < 8; ++db) kb[db] = rowb + (((2 * db + (p2 >> 1)) ^ xr) << 4);
        const bf16x8 ones = (bf16x8){0x3F80, 0x3F80, 0x3F80, 0x3F80, 0x3F80, 0x3F80, 0x3F80, 0x3F80};
#pragma unroll
        for (int ks = 0; ks < 4; ++ks) {
            const bf16x8 vf = cat44(tr_read(lds + vbase + ks * 8192), tr_read(lds + vbase + ks * 8192 + 4096));
#pragma unroll
            for (int db = 0; db < 8; ++db) {
                const bf16x8 kf = cat44(tr_read(lds + kb[db] + ks * 8192), tr_read(lds + kb[db] + ks * 8192 + 4096));
                acc[db] = mfma16(kf, vf, acc[db]);
                if (db == w) accn = mfma16(kf, ones, accn);
            }
        }
        bf16* kp = kvt + (size_t)idx * 16384 + (size_t)(16 * w + x) * 128 + 4 * g;
#pragma unroll
        for (int db = 0; db < 8; ++db) { v2u o; o.x = pk2(acc[db][0], acc[db][1]); o.y = pk2(acc[db][2], acc[db][3]); *(v2u*)(kp + 16 * db) = o; }
        if (x == 0) *(f32x4*)(nch + (size_t)idx * 128 + 16 * w + 4 * g) = accn;
        LBAR();
        if (!more) break;
        idx = idn;
    }
}

__device__ __forceinline__ void p3_scan_merge(const bf16* kvt, const float* nch, float* sc, bf16* cpt, float* nprev, const bf16* og, const float* lse, bf16* mix, int vcu, int G, int tid) {
    const int gid = vcu * (NWAVES * 64) + tid, NT = G * NWAVES * 64;
    for (int task = gid; task < 32 * 2048; task += NT) {
        const int bh = task >> 11, f8 = task & 2047;
        float C[8]; float m = -1e30f;
#pragma unroll
        for (int j = 0; j < 8; ++j) C[j] = 0.f;
        for (int c = 0; c < 32; ++c) {
            const int idx = bh * 32 + c; const float bl = sc[idx], mc = sc[1024 + idx];
            *(v4u*)(cpt + (size_t)idx * 16384 + 8 * f8) = pack8(C);
            if (f8 == 0) sc[2048 + idx] = m;
            const float mn = fmaxf(bl + m, mc), decay = expf(bl + m - mn), scale = expf(mc - mn);
            float kv[8]; unpack8(*(const v4u*)(kvt + (size_t)idx * 16384 + 8 * f8), kv);
#pragma unroll
            for (int j = 0; j < 8; ++j) C[j] = C[j] * decay + kv[j] * scale;
            m = mn;
        }
    }
    for (int task = gid; task < 32 * 32; task += NT) {
        const int bh = task >> 5, f4 = task & 31;
        f32x4 C = (f32x4){0.f, 0.f, 0.f, 0.f}; float m = -1e30f;
        for (int c = 0; c < 32; ++c) {
            const int idx = bh * 32 + c; const float bl = sc[idx], mc = sc[1024 + idx];
            *(f32x4*)(nprev + (size_t)idx * 128 + 4 * f4) = C;
            const float mn = fmaxf(bl + m, mc), decay = expf(bl + m - mn), scale = expf(mc - mn);
            const f32x4 kv = *(const f32x4*)(nch + (size_t)idx * 128 + 4 * f4);
            C = C * decay + kv * scale; m = mn;
        }
    }
    for (int task = gid; task < T * NH * 16; task += NT) {
        const int t = task >> 7, rem = task & 127, h = rem >> 4, ch = rem & 15;
        float w0 = lse[(size_t)h * T + t], w1 = lse[(size_t)(NH + h) * T + t], w2 = lse[(size_t)(2 * NH + h) * T + t];
        const float inv = 1.0f / (w0 + w1 + w2); w0 *= inv; w1 *= inv; w2 *= inv;
        const size_t o = ((size_t)h * T + t) * HD + ch * 8;
        float a[8], bq[8], cq[8]; unpack8(*(const v4u*)(og + o), a); unpack8(*(const v4u*)(og + (size_t)NH * T * HD + o), bq); unpack8(*(const v4u*)(og + (size_t)2 * NH * T * HD + o), cq);
#pragma unroll
        for (int j = 0; j < 8; ++j) a[j] = a[j] * w0 + bq[j] * w1 + cq[j] * w2;
        *(v4u*)(mix + (size_t)t * DM + h * 128 + ch * 8) = pack8(a);
    }
}

struct MCRegs { v4u kr[4], vr[4], qr[4], cr[4]; float u[4], bq, npv, mprev, umax; };
__device__ __forceinline__ void mC_prefetch(const bf16* proj, const float* gs, const bf16* kc, const bf16* mix, const bf16* cpt, const float* nprev, const float* sc, int idx, int tid, int lane, int w, MCRegs& R) {
    const int c = idx & 31, bh = idx >> 5, h = bh & 7, b = bh >> 3, rg = tid >> 4, ch = tid & 15;
    const size_t t0 = (size_t)b * SEQ + 128 * c;
    const unsigned vk = (unsigned)(rg * HD + ch * 8) * 2u, vq = (unsigned)(rg * DM + ch * 8) * 2u;
#pragma unroll
    for (int it = 0; it < 4; ++it) {
        R.kr[it] = *(const v4u*)((const char*)(kc + ((size_t)h * T + t0 + 32 * it) * HD) + vk);
        R.vr[it] = *(const v4u*)((const char*)(seg_ptr(proj, S_MV, h) + (t0 + 32 * it) * HD) + vk);
        R.qr[it] = *(const v4u*)((const char*)(mix + (t0 + 32 * it) * DM + AW + h * 128) + vq);
        R.cr[it] = *(const v4u*)((const char*)(cpt + (size_t)idx * 16384 + 32 * it * 128) + vk);
        R.u[it] = gs[(size_t)idx * 256 + 128 + 32 * it + rg];
    }
    R.bq = gs[(size_t)idx * 256 + 16 * w + (lane & 15)];
    R.npv = 0.f; if (tid < 128) R.npv = nprev[(size_t)idx * 128 + tid];
    R.mprev = __hip_atomic_load(sc + 2048 + idx, __ATOMIC_RELAXED, __HIP_MEMORY_SCOPE_AGENT);
    R.umax = __hip_atomic_load(sc + 3072 + idx, __ATOMIC_RELAXED, __HIP_MEMORY_SCOPE_AGENT);
}
template <int MODE = 0> __device__ __forceinline__ void mlstmC_phase(LAS unsigned char* lds, LAS float* sm, const bf16* proj, const float* gs, const bf16* kc, const bf16* cpt, const float* nprev, const float* sc,
                                             const float* __restrict__ ng, bf16* mix, int vcu, int G, int tid, int lane, int w) {
    int idx = vcu; if (idx >= 1024) return;
    int hcur = (vcu >> 5) & 7; if (tid < 128) sm[640 + tid] = ng[hcur * 128 + tid];
    MCRegs R; mC_prefetch(proj, gs, kc, mix, cpt, nprev, sc, idx, tid, lane, w, R);
    const int x = lane & 15, g = lane >> 4, rg = tid >> 4, ch = tid & 15;
    for (;;) {
        const int c = idx & 31, bh = idx >> 5, h = bh & 7, b = bh >> 3;
        const size_t t0 = (size_t)b * SEQ + 128 * c;
        if (h != hcur) { hcur = h; LBAR(); if (tid < 128) sm[640 + tid] = ng[hcur * 128 + tid]; }
        const float mprev = R.mprev, M = fmaxf(mprev, R.umax), cs = __expf(mprev - M), fl = __expf(-(R.bq + M));
#pragma unroll
        for (int it = 0; it < 4; ++it) {
            const int l = it * 32 + rg;
            const float cf = __expf(R.u[it] - M);
            float y[8]; unpack8(R.kr[it], y);
#pragma unroll
            for (int j = 0; j < 8; ++j) y[j] *= cf;
            *(LAS v4u*)(lds + kimg(l, ch)) = pack8(y);
            *(LAS v4u*)(lds + 32768 + vimg(l, ch)) = R.vr[it];
            *(LAS v4u*)(lds + 65536 + kimg(l, ch)) = R.cr[it];
            *(LAS v4u*)(lds + 98304 + kimg(l, ch)) = R.qr[it];
        }
        if (tid < 128) sm[512 + tid] = R.npv;
        LBAR();
        const int idn = idx + G; const bool more = idn < 1024;
        if (MODE != 2) mC_prefetch(proj, gs, kc, mix, cpt, nprev, sc, more ? idn : idx, tid, lane, w, R);
        if (MODE == 1) { LBAR(); if (!more) break; idx = idn; continue; }
        const int lq = 16 * w + x;
        v2u mor[8];
        const int q4 = x >> 2, p2 = x & 3;
        int rb[4];
#pragma unroll
        for (int s = 0; s < 4; ++s) rb[s] = x * 256 + (((4 * s + g) ^ x) << 4);
        bf16x8 qf[4]; float qn = 0.f;
#pragma unroll
        for (int s = 0; s < 4; ++s) {
            qf[s] = *(const LAS bf16x8*)(lds + 98304 + w * 4096 + rb[s]);
            float y[8]; unpack8(__builtin_bit_cast(v4u, qf[s]), y);
#pragma unroll
            for (int j = 0; j < 8; ++j) qn += y[j] * sm[512 + 32 * s + 8 * g + j];
        }
        qn += __shfl_xor(qn, 16); qn += __shfl_xor(qn, 32);
        f32x4 acc[8];
#pragma unroll
        for (int eb = 0; eb < 8; ++eb) acc[eb] = (f32x4){0.f, 0.f, 0.f, 0.f};
#pragma unroll
        for (int s = 0; s < 4; ++s)
#pragma unroll
            for (int hf = 0; hf < 2; ++hf) {
                bf16x8 ca[4];
#pragma unroll
                for (int e4 = 0; e4 < 4; ++e4) ca[e4] = *(const LAS bf16x8*)(lds + 65536 + (4 * hf + e4) * 4096 + rb[s]);
#pragma unroll
                for (int e4 = 0; e4 < 4; ++e4) acc[4 * hf + e4] = mfma16(ca[e4], qf[s], acc[4 * hf + e4]);
            }
#pragma unroll
        for (int eb = 0; eb < 8; ++eb) acc[eb] = acc[eb] * cs;
        const int xr = ((4 * g + q4) & 7) << 1;
        int vb[8];
#pragma unroll
        for (int eb = 0; eb < 8; ++eb) vb[eb] = 32768 + (4 * g + q4) * 256 + 8 * (p2 & 1) + (((2 * eb + (p2 >> 1)) ^ xr) << 4);
        float dsum = 0.f;
        {
            const bf16* mo = seg_ptr(proj, S_MO, h) + (t0 + lq) * HD + 4 * g;
#pragma unroll
            for (int eb = 0; eb < 8; ++eb) mor[eb] = *(const v2u*)(mo + 16 * eb); }
#pragma unroll 2
        for (int i = 0; i < 4; ++i) {
            f32x4 sc2[2];
#pragma unroll
            for (int h2 = 0; h2 < 2; ++h2) { bf16x8 ka[4];
#pragma unroll
                for (int s = 0; s < 4; ++s) ka[s] = *(const LAS bf16x8*)(lds + (2 * i + h2) * 4096 + rb[s]);
                sc2[h2] = (f32x4){0.f, 0.f, 0.f, 0.f};
#pragma unroll
                for (int s = 0; s < 4; ++s) sc2[h2] = mfma16(ka[s], qf[s], sc2[h2]); }
            float pe[2][4];
#pragma unroll
            for (int h2 = 0; h2 < 2; ++h2)
#pragma unroll
                for (int q = 0; q < 4; ++q) { const float v = (16 * (2 * i + h2) + 4 * g + q <= lq) ? sc2[h2][q] : 0.f; pe[h2][q] = v; dsum += v; }
            v4u pw; pw.x = pk2(pe[0][0], pe[0][1]); pw.y = pk2(pe[0][2], pe[0][3]); pw.z = pk2(pe[1][0], pe[1][1]); pw.w = pk2(pe[1][2], pe[1][3]);
            const bf16x8 pf = __builtin_bit_cast(bf16x8, pw);
#pragma unroll
            for (int hf = 0; hf < 2; ++hf) {
                s16x4 va[4][2];
#pragma unroll
                for (int e4 = 0; e4 < 4; ++e4) { va[e4][0] = tr_read(lds + vb[4 * hf + e4] + i * 8192); va[e4][1] = tr_read(lds + vb[4 * hf + e4] + i * 8192 + 4096); }
#pragma unroll
                for (int e4 = 0; e4 < 4; ++e4) acc[4 * hf + e4] = mfma16(cat44(va[e4][0], va[e4][1]), pf, acc[4 * hf + e4]);
            }
        }
        dsum += __shfl_xor(dsum, 16); dsum += __shfl_xor(dsum, 32);
        const float den = cs * qn + dsum, inv = 1.0f / fmaxf(fabsf(den), fl);
        float ss = 0.f;
#pragma unroll
        for (int eb = 0; eb < 8; ++eb) { acc[eb] = acc[eb] * inv; ss += (acc[eb][0] * acc[eb][0] + acc[eb][1] * acc[eb][1]) + (acc[eb][2] * acc[eb][2] + acc[eb][3] * acc[eb][3]); }
        ss += __shfl_xor(ss, 16); ss += __shfl_xor(ss, 32);
        const float rstd = __builtin_amdgcn_rsqf(ss * (1.f / HD) + EPS);
        bf16* op = mix + (t0 + lq) * DM + AW + h * 128 + 4 * g;
        const LAS float* ngp = sm + 640 + 4 * g;
#pragma unroll
        for (int eb = 0; eb < 8; ++eb) {
            const v2u mr = mor[eb]; const f32x4 gv = *(const LAS f32x4*)(ngp + 16 * eb);
            const float o0 = acc[eb][0] * rstd * gv.x * sigmf(bf_lo(mr.x)), o1 = acc[eb][1] * rstd * gv.y * sigmf(bf_hi(mr.x)), o2 = acc[eb][2] * rstd * gv.z * sigmf(bf_lo(mr.y)), o3 = acc[eb][3] * rstd * gv.w * sigmf(bf_hi(mr.y));
            v2u o; o.x = pk2(o0, o1); o.y = pk2(o2, o3); if (MODE == 0) *(v2u*)(op + 16 * eb) = o; else asm volatile("" :: "v"(o.x), "v"(o.y));
        }
        LBAR();
        if (!more) break;
        idx = idn;
    }
}

struct Args { const float* in[14]; float* out; unsigned char* ws; int ph_lo, ph_hi, li, pad; };
__global__ void __launch_bounds__(NWAVES * 64, 2) hyb_fwd(Args args) {
    extern __shared__ __attribute__((aligned(16))) unsigned char lds_raw[];
    LAS unsigned char* lds = (LAS unsigned char*)lds_raw;
    volatile LAS unsigned* MISC = (volatile LAS unsigned*)(lds + MISC_OFF);
    LAS float* sm = (LAS float*)(lds + SM_OFF);
    const int tid = threadIdx.x, lane = tid & 63, wave = __builtin_amdgcn_readfirstlane(tid >> 6);
    const int G = gridDim.x; const int bx = blockIdx.x; const int vcu = (G % 8 == 0) ? (bx % 8) * (G / 8) + bx / 8 : bx;
    unsigned char* ws = args.ws;
    gu32* ctl = (gu32*)(ws + WS_CTL);
    for (int u = tid; u < (LDS_BYTES - LDSCTL_OFF) / 4; u += NWAVES * 64) ((LAS unsigned*)(lds + LDSCTL_OFF))[u] = 0u;
    __syncthreads();
    const XcdBarrier bar = xcd_barrier_post((unsigned*)(ctl + CW_BAR) + args.li * XCD_BAR_WORDS, MISC + 8);
#define GRID_BAR() xcd_barrier(bar)
#ifdef PROBE_T
#define STAMP(k) do { if (bx == 0 && tid == 0) MISC[16 + (k)] = (unsigned)wall_clock64(); } while (0)
#else
#define STAMP(k) do { } while (0)
#endif
    STAMP(0);
    const int lo = args.ph_lo, hi = args.ph_hi;
#ifndef PH_MASK
#define PH_MASK 0xffffff
#endif
#define IN(k) (((PH_MASK >> (k)) & 1) && lo <= (k) && (k) < hi)
#define BOTH(k) (IN(k) && IN((k) + 1))

    bf16* WIN = (bf16*)(ws + WS_WIN); bf16* WOUT = (bf16*)(ws + WS_WOUT); bf16* WGU = (bf16*)(ws + WS_WGU); bf16* WDN = (bf16*)(ws + WS_WDN);
    bf16* HB = (bf16*)(ws + WS_HB); bf16* KVT = (bf16*)(ws + WS_HB); bf16* PROJ = (bf16*)(ws + WS_PROJ); bf16* HID = (bf16*)(ws + WS_PROJ); bf16* MIX = (bf16*)(ws + WS_MIX);
    float* GATES = (float*)(ws + WS_GATES); float* LSE = (float*)(ws + WS_LSE); float* NCHK = (float*)(ws + WS_NCH); float* NPREV = (float*)(ws + WS_NPREV); float* SC = (float*)(ws + WS_SC);
    float* ROWSS = (float*)(ws + WS_CTL) + CW_ROWSS; bf16* KC = (bf16*)(ws + WS_KC); float* GS = (float*)(ws + WS_GS);
    bf16* OG = (bf16*)((unsigned char*)args.out + DO_ATT); bf16* CPT = (bf16*)((unsigned char*)args.out + DO_CPT);

    if (IN(0)) { p0_prologue<3>(lds, sm, args.in, ws, vcu, G, tid, lane, wave); if (BOTH(0)) GRID_BAR(); STAMP(1); }
#ifdef PROBE_P0
    if (IN(8)) p0_prologue<1>(lds, sm, args.in, ws, vcu, G, tid, lane, wave);
    if (IN(9)) p0_prologue<2>(lds, sm, args.in, ws, vcu, G, tid, lane, wave);
#endif

    if (IN(1)) {
        pg8::Gemm g{HB, WIN, T, PJ, DM}; pg8::StaticOrder S; S.init(T, PJ, G, bx);
        pg8::EpiProj E{PROJ, T, args.in[6], args.in[7], sm, EPS, RSQRT_HD * LOG2E};
        pg8::gemm_phase<pg8::EpiProj, pg8::StaticOrder, true, true>(lds, g, S, E);
        if (BOTH(1)) GRID_BAR(); STAMP(2);
    }

    if (IN(2)) {
        attn_phase<0>(lds, PROJ, OG, LSE, args.in[6], args.in[7], vcu, G, tid, lane, wave); STAMP(9);
        mlstmA_phase(lds, sm, PROJ, GATES, args.in[3], args.in[4], KVT, NCHK, SC, GS, KC, MIX, vcu, G, tid, lane, wave);
        if (BOTH(2)) GRID_BAR(); STAMP(3);
    }

#ifdef PROBE_P2
    if (IN(10)) attn_phase<0>(lds, PROJ, OG, LSE, args.in[6], args.in[7], vcu, G, tid, lane, wave);
    if (IN(12)) attn_phase<1>(lds, PROJ, OG, LSE, args.in[6], args.in[7], vcu, G, tid, lane, wave);
    if (IN(13)) attn_phase<2>(lds, PROJ, OG, LSE, args.in[6], args.in[7], vcu, G, tid, lane, wave);
    if (IN(11)) mlstmA_phase(lds, sm, PROJ, GATES, args.in[3], args.in[4], KVT, NCHK, SC, GS, KC, MIX, vcu, G, tid, lane, wave);
#endif
    if (IN(3)) { p3_scan_merge(KVT, NCHK, SC, CPT, NPREV, OG, LSE, MIX, vcu, G, tid); if (BOTH(3)) GRID_BAR(); STAMP(4); }

    if (IN(4)) {
        mlstmC_phase<0>(lds, sm, PROJ, GS, KC, CPT, NPREV, SC, args.in[8], MIX, vcu, G, tid, lane, wave);
        if (BOTH(4)) GRID_BAR(); STAMP(5);
    }

#ifdef PROBE_P4
    if (IN(15)) mlstmC_phase<1>(lds, sm, PROJ, GS, KC, CPT, NPREV, SC, args.in[8], MIX, vcu, G, tid, lane, wave);
    if (IN(16)) mlstmC_phase<2>(lds, sm, PROJ, GS, KC, CPT, NPREV, SC, args.in[8], MIX, vcu, G, tid, lane, wave);
#endif
    if (IN(5)) {
        pg8::Gemm g{MIX, WOUT, T, DM, DM}; pg8::StaticOrder S; S.init(T, DM, G, bx);
        pg8::EpiRes1 E{args.in[0], args.out, HB, ROWSS, DM};
        pg8::gemm_phase<pg8::EpiRes1, pg8::StaticOrder, false, true>(lds, g, S, E);
        if (BOTH(5)) GRID_BAR(); STAMP(6);
    }

#ifdef PROBE_SLEEP
    { const long long until = wall_clock64() + 10000; while (wall_clock64() < until) __builtin_amdgcn_s_sleep(32); }
#endif
    if (IN(6)) {
        pg8::Gemm g{HB, WGU, T, 2 * FF, DM}; pg8::StaticOrder S; S.init(T, 2 * FF, G, bx);
        pg8::EpiSwi E{HID, FF, ROWSS, EPS};
        pg8::gemm_phase<pg8::EpiSwi, pg8::StaticOrder, false, true>(lds, g, S, E);
        if (BOTH(6)) GRID_BAR(); STAMP(7);
    }

#ifdef PROBE_G
    if (IN(17)) { pg8::Gemm g{PROJ, PROJ + (size_t)T * DM, T, 2 * FF, DM}; pg8::StaticOrder S; S.init(T, 2 * FF, G, bx); pg8::EpiNone E{}; pg8::gemm_phase<pg8::EpiNone, pg8::StaticOrder, true, true>(lds, g, S, E); }
    if (IN(14)) { pg8::Gemm g{HB, WGU, T, 2 * FF, DM}; pg8::StaticOrder S; S.init(T, 2 * FF, G, bx); pg8::EpiNone E{}; pg8::gemm_phase<pg8::EpiNone, pg8::StaticOrder, true, true>(lds, g, S, E); }
#endif
    if (IN(7)) {
        pg8::Gemm g{HID, WDN, T, DM, FF}; pg8::StaticOrder S; S.init(T, DM, G, bx);
        pg8::EpiRes2 E{args.out, DM};
        pg8::gemm_phase<pg8::EpiRes2, pg8::StaticOrder, false, true>(lds, g, S, E);
    }
    STAMP(8);
#ifdef PROBE_T
    if (bx == 0 && tid == 0) {
#ifdef PROBE_TA
        const unsigned dt = MISC[16 + PROBE_TB] - MISC[16 + PROBE_TA];
#else
        const unsigned dt = MISC[16 + PROBE_T + 1] - MISC[16 + PROBE_T];
#endif
        const long long until = wall_clock64() + (long long)dt * 10;
        while (wall_clock64() < until) __builtin_amdgcn_s_sleep(8); }
#endif
#undef IN
#undef BOTH
}

extern "C" void kernel_launch(void* const* d_in, const int* in_sizes, int n_in, void* d_out, int out_size, void* d_ws, size_t ws_size, hipStream_t stream) {
    static int grid = 0;
    if (grid == 0) {
        if (n_in != 14 || in_sizes[0] != T * DM || out_size != T * DM || ws_size < WS_END) { fprintf(stderr, "kernel_launch: unexpected shapes (n_in %d, in0 %d, out %d, ws %zu); nothing launched\n", n_in, n_in > 0 ? in_sizes[0] : -1, out_size, ws_size); grid = -1; return; }
        int dev = 0, cus = 0, per_cu = 0;
        if (hipGetDevice(&dev) != hipSuccess || hipDeviceGetAttribute(&cus, hipDeviceAttributeMultiprocessorCount, dev) != hipSuccess) { fprintf(stderr, "kernel_launch: hipGetDevice / hipDeviceGetAttribute failed\n"); grid = -1; return; }
        if (hipFuncSetAttribute((const void*)hyb_fwd, hipFuncAttributeMaxDynamicSharedMemorySize, LDS_BYTES) != hipSuccess) { fprintf(stderr, "kernel_launch: hipFuncSetAttribute failed\n"); grid = -1; return; }
        if (hipOccupancyMaxActiveBlocksPerMultiprocessor(&per_cu, (const void*)hyb_fwd, NWAVES * 64, LDS_BYTES) != hipSuccess || per_cu < 1)
            fprintf(stderr, "kernel_launch: note: occupancy query reports %d workgroups per CU\n", per_cu);
        (void)hipGetLastError();
        grid = cus;
    }
    if (grid < 0) return;
    if (hipMemsetAsync((char*)d_ws + WS_CTL, 0, CTL_ZERO_BYTES, stream) != hipSuccess) { fprintf(stderr, "kernel_launch: hipMemsetAsync failed\n"); return; }
    Args a{};
    for (int i = 0; i < 14; ++i) a.in[i] = (const float*)d_in[i];
    a.out = (float*)d_out; a.ws = (unsigned char*)d_ws;
    static const int plist[] = PHASE_LIST;
    constexpr int NL = (int)(sizeof(plist) / sizeof(int)) / 2;
    static_assert(NL >= 1 && NL <= 16, "launch list");
    for (int li = 0; li < NL; ++li) {
        a.ph_lo = plist[2 * li]; a.ph_hi = plist[2 * li + 1]; a.li = li;
        hipLaunchKernelGGL(hyb_fwd, dim3(grid), dim3(NWAVES * 64), LDS_BYTES, stream, a);
        const hipError_t le = hipPeekAtLastError();
        if (le != hipSuccess) { fprintf(stderr, "kernel_launch: launch %d failed: %s\n", li, hipGetErrorName(le)); break; }
    }
}
```

```cpp
#include <hip/hip_runtime.h>
#include <cstdio>
#include <cstdint>
namespace pg8 {
#define PG8_LAS __attribute__((address_space(3)))
typedef unsigned short bf16_t;
typedef short bf16x8 __attribute__((ext_vector_type(8)));
typedef float f32x4 __attribute__((ext_vector_type(4)));
typedef unsigned u32x4 __attribute__((ext_vector_type(4)));
constexpr int BM = 256, BK = 64, HALF = 128, HTB = HALF * BK * 2  , STAGE_BYTES = 8 * HTB, NXCD = 8, WGM = 8;

__host__ __device__ __forceinline__ int lds_byte(int r, int c) { const int st = (r >> 4) * 2 + (c >> 5), rr = r & 15, cc = c & 31, ob = rr * 64 + cc * 2; return st * 1024 + (ob ^ (((ob >> 9) & 1) << 5)); }
__host__ __device__ __forceinline__ void stage_rc(int b, int& R, int& C) { const int st = b / 1024, sb = b % 1024, swz = sb ^ (((sb >> 9) & 1) << 5); R = (st >> 1) * 16 + swz / 64; C = (st & 1) * 32 + (swz % 64) / 2; }
__host__ __device__ __forceinline__ int perm32(int rho) { const int n = rho >> 4, i = rho & 15; return 8 * (i >> 2) + 4 * n + (i & 3); }

struct Unit { int pm, pn; };
struct Gemm { const bf16_t* A; const bf16_t* Bt; int M, N, K; };

struct StaticOrder {
    int nM, nN, nwg, G, c;
    __host__ __device__ void init(int M, int N, int G_, int c_) { nM = M / BM; nN = N / BM; nwg = nM * nN; G = G_; c = c_; }
    __host__ __device__ bool next(int i, Unit& u) const {
        const long L = (long)i * G + c; if (L >= nwg) return false;
        int wgid = (int)L; { const int q = nwg / NXCD, r = nwg % NXCD, xcd = wgid % NXCD, off = wgid / NXCD; wgid = (xcd < r ? xcd * (q + 1) : r * (q + 1) + (xcd - r) * q) + off; }
        const int nig = WGM * nN, gid = wgid / nig, fm = gid * WGM, gsz = (nM - fm) < WGM ? (nM - fm) : WGM;
        u.pm = fm + ((wgid % nig) % gsz); u.pn = (wgid % nig) / gsz; return true;
    }
    __device__ __forceinline__ void a_ready(const Unit&) const {}
    __device__ __forceinline__ void done(const Unit&) const {}
};
typedef float f32x2 __attribute__((ext_vector_type(2)));
typedef __bf16 bf16x2_t __attribute__((ext_vector_type(2)));
typedef unsigned u32x2 __attribute__((ext_vector_type(2)));
__device__ __forceinline__ unsigned cvt_pk_bf16(float lo, float hi) { f32x2 v = {lo, hi}; bf16x2_t b = __builtin_convertvector(v, bf16x2_t); return __builtin_bit_cast(unsigned, b); }

struct EpiProj {
    static constexpr bool PERM = true, AFTER_DRAIN = false;
    bf16_t* O; int ldc  ; const float* qg; const float* kg; PG8_LAS float* sm; float eps, qscale;
    __device__ __forceinline__ void operator()(const f32x4 (&acc)[2][2][4][2], const Unit& u, int wr, int wc, int fr, int fq) const {
        const int row0 = u.pm * BM + wr * 64 + fr, col0 = wc * 32 + 8 * fq;
        bf16_t* const slab = O + (size_t)(2 * u.pn) * ldc * HALF;
        if (u.pn < 8) {
            const float* gsrc = (u.pn < 4 ? qg : kg) + wc * 32 + 8 * fq; const float extra = u.pn < 4 ? qscale : 1.0f;
            const f32x4 ga = *(const f32x4*)gsrc, gb = *(const f32x4*)(gsrc + 4);
#pragma unroll
            for (int ai = 0; ai < 2; ++ai)
#pragma unroll
                for (int m = 0; m < 4; ++m)
#pragma unroll
                    for (int bj = 0; bj < 2; ++bj) { const f32x4 v0 = acc[ai][bj][m][0], v1 = acc[ai][bj][m][1];
                        float s = ((v0[0] * v0[0] + v0[1] * v0[1]) + (v0[2] * v0[2] + v0[3] * v0[3])) + ((v1[0] * v1[0] + v1[1] * v1[1]) + (v1[2] * v1[2] + v1[3] * v1[3]));
                        s += __shfl_xor(s, 16); s += __shfl_xor(s, 32);
                        if (fq == 0) sm[((ai * HALF + wr * 64 + m * 16 + fr) * 2 + bj) * 4 + wc] = s; }
            asm volatile("s_waitcnt lgkmcnt(0)" ::: "memory"); __builtin_amdgcn_s_barrier(); asm volatile("" ::: "memory");
#pragma unroll
            for (int ai = 0; ai < 2; ++ai)
#pragma unroll
                for (int m = 0; m < 4; ++m) { bf16_t* rowp = slab + (size_t)(row0 + ai * HALF + m * 16) * HALF + col0;
#pragma unroll
                    for (int bj = 0; bj < 2; ++bj) { const f32x4 pv = *(const PG8_LAS f32x4*)(sm + ((ai * HALF + wr * 64 + m * 16 + fr) * 2 + bj) * 4);
                        const float rs = __builtin_amdgcn_rsqf(((pv[0] + pv[1]) + (pv[2] + pv[3])) * (1.0f / 128.0f) + eps) * extra;
                        const f32x4 v0 = acc[ai][bj][m][0] * ga * rs, v1 = acc[ai][bj][m][1] * gb * rs;
                        u32x4 w; w.x = cvt_pk_bf16(v0[0], v0[1]); w.y = cvt_pk_bf16(v0[2], v0[3]); w.z = cvt_pk_bf16(v1[0], v1[1]); w.w = cvt_pk_bf16(v1[2], v1[3]);
                        *(u32x4*)(rowp + (size_t)bj * ldc * HALF) = w; } }
            asm volatile("s_waitcnt lgkmcnt(0)" ::: "memory"); __builtin_amdgcn_s_barrier(); asm volatile("" ::: "memory");
            return;
        }
#pragma unroll
        for (int ai = 0; ai < 2; ++ai)
#pragma unroll
            for (int m = 0; m < 4; ++m) { bf16_t* rowp = slab + (size_t)(row0 + ai * HALF + m * 16) * HALF + col0;
#pragma unroll
                for (int bj = 0; bj < 2; ++bj) { const f32x4 v0 = acc[ai][bj][m][0], v1 = acc[ai][bj][m][1];
                    u32x4 w; w.x = cvt_pk_bf16(v0[0], v0[1]); w.y = cvt_pk_bf16(v0[2], v0[3]); w.z = cvt_pk_bf16(v1[0], v1[1]); w.w = cvt_pk_bf16(v1[2], v1[3]);
                    *(u32x4*)(rowp + (size_t)bj * ldc * HALF) = w; } }
    }
};
struct EpiRes1 {
    static constexpr bool PERM = true, AFTER_DRAIN = false, INIT = false;
    const float* X; float* X1; bf16_t* X1B; float* rowss; int ldc;
    __device__ __forceinline__ void operator()(const f32x4 (&acc)[2][2][4][2], const Unit& u, int wr, int wc, int fr, int fq) const {
        const int row0 = u.pm * BM + wr * 64 + fr, col0 = u.pn * BM + wc * 32 + 8 * fq;
#pragma unroll
        for (int ai = 0; ai < 2; ++ai)
#pragma unroll
            for (int m = 0; m < 4; ++m) { const int r = row0 + ai * HALF + m * 16; const size_t off = (size_t)r * ldc + col0; float ss = 0.f;
#pragma unroll
                for (int bj = 0; bj < 2; ++bj) { const size_t c = off + bj * HALF;
                    const f32x4 v0 = __builtin_nontemporal_load((const f32x4*)(X + c)) + acc[ai][bj][m][0], v1 = __builtin_nontemporal_load((const f32x4*)(X + c + 4)) + acc[ai][bj][m][1];
                    *(f32x4*)(X1 + c) = v0; *(f32x4*)(X1 + c + 4) = v1;
                    ss += ((v0[0] * v0[0] + v0[1] * v0[1]) + (v0[2] * v0[2] + v0[3] * v0[3])) + ((v1[0] * v1[0] + v1[1] * v1[1]) + (v1[2] * v1[2] + v1[3] * v1[3]));
                    u32x4 w; w.x = cvt_pk_bf16(v0[0], v0[1]); w.y = cvt_pk_bf16(v0[2], v0[3]); w.z = cvt_pk_bf16(v1[0], v1[1]); w.w = cvt_pk_bf16(v1[2], v1[3]); *(u32x4*)(X1B + c) = w; }
                ss += __shfl_xor(ss, 16); ss += __shfl_xor(ss, 32);
                if (fq == 0) atomicAdd(rowss + r, ss);
                if (m == 3) asm volatile("" ::: "memory"); }
    }
};
struct EpiSwi {
    static constexpr bool PERM = true, AFTER_DRAIN = false;
    bf16_t* H; int ldc; const float* rowss; float eps;
    __device__ __forceinline__ void operator()(const f32x4 (&acc)[2][2][4][2], const Unit& u, int wr, int wc, int fr, int fq) const {
        const int row0 = u.pm * BM + wr * 64 + fr, col0 = u.pn * HALF + wc * 32 + 8 * fq;
        float rsv[2][4];
#pragma unroll
        for (int ai = 0; ai < 2; ++ai)
#pragma unroll
            for (int m = 0; m < 4; ++m) rsv[ai][m] = rowss[row0 + ai * HALF + m * 16];
#pragma unroll
        for (int ai = 0; ai < 2; ++ai)
#pragma unroll
            for (int m = 0; m < 4; ++m) { const int r = row0 + ai * HALF + m * 16; const float s = __builtin_amdgcn_rsqf(rsv[ai][m] * (1.0f / 2048.0f) + eps);
                float hv[8];
#pragma unroll
                for (int n = 0; n < 2; ++n)
#pragma unroll
                    for (int j = 0; j < 4; ++j) { const float g = acc[ai][0][m][n][j] * s, up = acc[ai][1][m][n][j] * s; hv[n * 4 + j] = g * __builtin_amdgcn_rcpf(1.0f + __expf(-g)) * up; }
                u32x4 w; w.x = cvt_pk_bf16(hv[0], hv[1]); w.y = cvt_pk_bf16(hv[2], hv[3]); w.z = cvt_pk_bf16(hv[4], hv[5]); w.w = cvt_pk_bf16(hv[6], hv[7]);
                *(u32x4*)(H + (size_t)r * ldc + col0) = w; }
    }
};
struct EpiNone {
    static constexpr bool PERM = true, AFTER_DRAIN = false;
    __device__ __forceinline__ void operator()(const f32x4 (&acc)[2][2][4][2], const Unit& u, int wr, int wc, int fr, int fq) const {
#pragma unroll
        for (int ai = 0; ai < 2; ++ai)
#pragma unroll
            for (int m = 0; m < 4; ++m)
#pragma unroll
                for (int bj = 0; bj < 2; ++bj) asm volatile("" :: "v"(acc[ai][bj][m][0]), "v"(acc[ai][bj][m][1]));
    }
};
struct EpiRes2 {
    static constexpr bool PERM = true, AFTER_DRAIN = false, INIT = false;
    float* OUT; int ldc;
    __device__ __forceinline__ void operator()(const f32x4 (&acc)[2][2][4][2], const Unit& u, int wr, int wc, int fr, int fq) const {
        const int row0 = u.pm * BM + wr * 64 + fr, col0 = u.pn * BM + wc * 32 + 8 * fq;
#pragma unroll
        for (int ai = 0; ai < 2; ++ai)
#pragma unroll
            for (int m = 0; m < 4; ++m) { float* rowp = OUT + (size_t)(row0 + ai * HALF + m * 16) * ldc + col0;
#pragma unroll
                for (int bj = 0; bj < 2; ++bj) { f32x4* p = (f32x4*)(rowp + bj * HALF); const f32x4 a = p[0] + acc[ai][bj][m][0], b = p[1] + acc[ai][bj][m][1]; p[0] = a; p[1] = b; }
                if (m == 3) asm volatile("" ::: "memory"); }
    }
};

template <class Epi, class Sched, bool ALIGN_EPI = false, bool SP2 = false>
__device__ __forceinline__ void gemm_phase(PG8_LAS unsigned char* lds, const Gemm g, const Sched& S, const Epi& E) {
    const int tid = threadIdx.x, wid = __builtin_amdgcn_readfirstlane(tid >> 6), lane = tid & 63, wr = wid >> 2, wc = wid & 3, fr = lane & 15, fq = lane >> 4;
    const int K = g.K, nt = K / BK;
    unsigned voffA[2], voffB[2];
#pragma unroll
    for (int i = 0; i < 2; ++i) { int R, C; stage_rc(tid * 16 + i * 8192, R, C); const int Rb = Epi::PERM ? ((R & ~31) + perm32(R & 31)) : R;
        voffA[i] = (unsigned)(R * K + C) * 2u; voffB[i] = (unsigned)(Rb * K + C) * 2u; }
    const size_t kstep = (size_t)(BK * 2);
    const size_t hstep = (size_t)HALF * K * 2;
    const size_t tstep = 2 * hstep;
    const unsigned ldsw = (unsigned)wid * 1024u;
    const int aoff = lds_byte(wr * 64 + fr, fq * 8), boff = lds_byte(wc * 32 + fr, fq * 8);
#define PG8_SA(b, h) (((b) * 2 + (h)) * HTB)
#define PG8_SB(b, h) ((4 + (b) * 2 + (h)) * HTB)
#define PG8_STAGE(bufoff, gbase, voff) do { _Pragma("unroll") for (int _i = 0; _i < 2; ++_i) \
        __builtin_amdgcn_global_load_lds((const unsigned*)((const char*)(gbase) + (voff)[_i]), (PG8_LAS unsigned*)(lds + (bufoff) + ldsw + _i * 8192), 16, 0, 0); } while (0)
#define PG8_LDA(dst, b, h) do { _Pragma("unroll") for (int m = 0; m < 4; ++m) _Pragma("unroll") for (int k = 0; k < 2; ++k) dst[m][k] = *(const PG8_LAS bf16x8*)(lds + PG8_SA(b, h) + aoff + m * 2048 + k * 1024); } while (0)
#define PG8_LDB(dst, b, h) do { _Pragma("unroll") for (int n = 0; n < 2; ++n) _Pragma("unroll") for (int k = 0; k < 2; ++k) dst[n][k] = *(const PG8_LAS bf16x8*)(lds + PG8_SB(b, h) + boff + n * 2048 + k * 1024); } while (0)
#define PG8_MMA(ai, bj, At, Bt) do { __builtin_amdgcn_s_setprio(1); _Pragma("unroll") for (int m = 0; m < 4; ++m) _Pragma("unroll") for (int n = 0; n < 2; ++n) _Pragma("unroll") for (int k = 0; k < 2; ++k) \
        acc[ai][bj][m][n] = __builtin_amdgcn_mfma_f32_16x16x32_bf16(Bt[n][k], At[m][k], acc[ai][bj][m][n], 0, 0, 0); __builtin_amdgcn_s_setprio(0); } while (0)
#define PG8_WAIT_V(n) asm volatile("s_waitcnt vmcnt(" #n ")" ::: "memory")
#define PG8_WAIT_L(n) asm volatile("s_waitcnt lgkmcnt(" #n ")" ::: "memory")
#define PG8_BAR __builtin_amdgcn_s_barrier()
#define PG8_SCHED __builtin_amdgcn_sched_barrier(0)
    Unit cur, nxt; int ui = 0;
    if (!S.next(0, cur)) return;
    f32x4 acc[2][2][4][2];
#pragma unroll
    for (int a = 0; a < 2; ++a)
#pragma unroll
        for (int b = 0; b < 2; ++b)
#pragma unroll
            for (int m = 0; m < 4; ++m)
#pragma unroll
                for (int n = 0; n < 2; ++n) acc[a][b][m][n] = (f32x4){0.f, 0.f, 0.f, 0.f};
    bf16x8 At[4][2], B0[2][2], B1[2][2];
    const char* cA = (const char*)g.A + (size_t)cur.pm * tstep; const char* cB = (const char*)g.Bt + (size_t)cur.pn * tstep;
    S.a_ready(cur);
    if constexpr (SP2) {
        PG8_STAGE(PG8_SB(0, 0), cB, voffB); PG8_STAGE(PG8_SB(0, 1), cB + hstep, voffB); PG8_STAGE(PG8_SA(0, 0), cA, voffA); PG8_STAGE(PG8_SA(0, 1), cA + hstep, voffA);
        if (wr == 1) PG8_BAR;
        PG8_WAIT_V(2); PG8_BAR;
        PG8_STAGE(PG8_SB(1, 0), cB + kstep, voffB); PG8_STAGE(PG8_SA(1, 0), cA + kstep, voffA); PG8_STAGE(PG8_SB(1, 1), cB + hstep + kstep, voffB);
        PG8_WAIT_V(6); PG8_BAR;
    } else {
        PG8_STAGE(PG8_SB(0, 0), cB, voffB); PG8_STAGE(PG8_SA(0, 0), cA, voffA); PG8_STAGE(PG8_SB(0, 1), cB + hstep, voffB); PG8_STAGE(PG8_SA(0, 1), cA + hstep, voffA);
        if (wr == 1) PG8_BAR;
        PG8_WAIT_V(4); PG8_BAR;
        PG8_STAGE(PG8_SB(1, 0), cB + kstep, voffB); PG8_STAGE(PG8_SA(1, 0), cA + kstep, voffA); PG8_STAGE(PG8_SB(1, 1), cB + hstep + kstep, voffB);
        PG8_WAIT_V(6); PG8_BAR;
    }
    for (;;) {
        const bool has_next = S.next(ui + 1, nxt);
        const char* nA = has_next ? (const char*)g.A + (size_t)nxt.pm * tstep : cA; const char* nB = has_next ? (const char*)g.Bt + (size_t)nxt.pn * tstep : cB;
        for (int t = 0; t < nt; t += 2) {
            const bool last = (t == nt - 2);
            const char* a1 = cA + (size_t)(t + 1) * kstep;
            const char* a2 = last ? nA : cA + (size_t)(t + 2) * kstep; const char* b2 = last ? nB : cB + (size_t)(t + 2) * kstep;
            const char* a3 = a2 + kstep; const char* b3 = b2 + kstep;
            if (last && has_next) S.a_ready(nxt);
            if constexpr (SP2) {
            PG8_LDB(B0, 0, 0); PG8_LDB(B1, 0, 1); PG8_SCHED; PG8_LDA(At, 0, 0); PG8_STAGE(PG8_SA(1, 1), a1 + hstep, voffA);
            PG8_WAIT_V(8); PG8_WAIT_L(0); PG8_BAR; PG8_MMA(0, 0, At, B0); PG8_MMA(0, 1, At, B1); PG8_BAR; PG8_SCHED;
            PG8_LDA(At, 0, 1); PG8_STAGE(PG8_SB(0, 0), b2, voffB); PG8_STAGE(PG8_SB(0, 1), b2 + hstep, voffB); PG8_STAGE(PG8_SA(0, 0), a2, voffA);
            PG8_WAIT_V(8); PG8_WAIT_L(0); PG8_BAR; PG8_MMA(1, 0, At, B0); PG8_MMA(1, 1, At, B1); PG8_BAR; PG8_SCHED;
            PG8_LDB(B0, 1, 0); PG8_LDB(B1, 1, 1); PG8_SCHED; PG8_LDA(At, 1, 0); PG8_STAGE(PG8_SA(0, 1), a2 + hstep, voffA);
            PG8_WAIT_V(8); PG8_WAIT_L(0); PG8_BAR; PG8_MMA(0, 0, At, B0); PG8_MMA(0, 1, At, B1); PG8_BAR; PG8_SCHED;
            PG8_LDA(At, 1, 1); PG8_STAGE(PG8_SB(1, 0), b3, voffB); PG8_STAGE(PG8_SB(1, 1), b3 + hstep, voffB); PG8_STAGE(PG8_SA(1, 0), a3, voffA);
            PG8_WAIT_V(8); PG8_WAIT_L(0); PG8_BAR; PG8_MMA(1, 0, At, B0); PG8_MMA(1, 1, At, B1); PG8_BAR; PG8_SCHED;
            } else {
            PG8_LDB(B0, 0, 0); PG8_SCHED; PG8_LDA(At, 0, 0); PG8_STAGE(PG8_SA(1, 1), a1 + hstep, voffA);
            PG8_WAIT_L(8); PG8_BAR; PG8_WAIT_L(0); PG8_MMA(0, 0, At, B0); PG8_BAR; PG8_SCHED;
            PG8_LDB(B1, 0, 1); PG8_STAGE(PG8_SB(0, 0), b2, voffB);
            PG8_BAR; PG8_WAIT_L(0); PG8_MMA(0, 1, At, B1); PG8_BAR;
            PG8_LDA(At, 0, 1); PG8_STAGE(PG8_SA(0, 0), a2, voffA);
            PG8_BAR; PG8_WAIT_L(0); PG8_MMA(1, 0, At, B0); PG8_BAR; PG8_SCHED;
            PG8_STAGE(PG8_SB(0, 1), b2 + hstep, voffB);
            PG8_WAIT_V(6); PG8_BAR; PG8_MMA(1, 1, At, B1); PG8_BAR;
            PG8_LDB(B0, 1, 0); PG8_SCHED; PG8_LDA(At, 1, 0); PG8_STAGE(PG8_SA(0, 1), a2 + hstep, voffA);
            PG8_WAIT_L(8); PG8_BAR; PG8_WAIT_L(0); PG8_MMA(0, 0, At, B0); PG8_BAR; PG8_SCHED;
            PG8_LDB(B1, 1, 1); PG8_STAGE(PG8_SB(1, 0), b3, voffB);
            PG8_BAR; PG8_WAIT_L(0); PG8_MMA(0, 1, At, B1); PG8_BAR;
            PG8_LDA(At, 1, 1); PG8_STAGE(PG8_SA(1, 0), a3, voffA);
            PG8_BAR; PG8_WAIT_L(0); PG8_MMA(1, 0, At, B0); PG8_BAR; PG8_SCHED;
            PG8_STAGE(PG8_SB(1, 1), b3 + hstep, voffB);
            PG8_WAIT_V(6); PG8_BAR; PG8_MMA(1, 1, At, B1); PG8_BAR;
            }
        }
        if constexpr (ALIGN_EPI) { if (wr == 0) PG8_BAR; }
        if constexpr (!Epi::AFTER_DRAIN) { E(acc, cur, wr, wc, fr, fq); S.done(cur); }
        if (!has_next) break;
#pragma unroll
        for (int a = 0; a < 2; ++a)
#pragma unroll
            for (int b = 0; b < 2; ++b)
#pragma unroll
                for (int m = 0; m < 4; ++m)
#pragma unroll
                    for (int n = 0; n < 2; ++n) acc[a][b][m][n] = (f32x4){0.f, 0.f, 0.f, 0.f};
        cur = nxt; cA = nA; cB = nB; ++ui;
        if constexpr (ALIGN_EPI) { if (wr == 1) PG8_BAR; }
    }
    PG8_WAIT_V(0);
    if constexpr (!ALIGN_EPI) { if (wr == 0) PG8_BAR; }
    PG8_BAR;
    if constexpr (Epi::AFTER_DRAIN) { E.fused(acc, cur, wr, wc, fr, fq, lds, wid, lane); S.done(cur); }
#undef PG8_SA
#undef PG8_SB
#undef PG8_STAGE
#undef PG8_LDA
#undef PG8_LDB
#undef PG8_MMA
#undef PG8_WAIT_V
#undef PG8_WAIT_L
#undef PG8_BAR
#undef PG8_SCHED
}
}

constexpr int NWAVES = 8;
#ifndef PHASE_LIST
#define PHASE_LIST {0, 8}
#endif
constexpr int N_PHASES = 8;

constexpr int BATCH = 4, SEQ = 4096, DM = 2048, HD = 128, NH = 8, AW = 1024, FF = 5632;
constexpr int T = BATCH * SEQ;
constexpr int INW = 7184, PJ = 7168;
constexpr int S_AQ = 0, S_AK = 1, S_AV = 2, S_MQ = 3, S_MK = 4, S_MV = 5, S_MO = 6;
constexpr int NCH = SEQ / 128;
constexpr float EPS = 1e-6f;
constexpr float LOG2E = 1.4426950408889634f, LN2 = 0.6931471805599453f;
constexpr float RSQRT_HD = 0.08838834764831845f;

constexpr size_t MiB = 1u << 20;
constexpr size_t WS_CTL = 0, CTL_ZERO_BYTES = 1 * MiB;
constexpr size_t WS_WIN = 1 * MiB;
constexpr size_t WS_WOUT = 29 * MiB;
constexpr size_t WS_WGU = 37 * MiB;
constexpr size_t WS_WDN = 81 * MiB;
constexpr size_t WS_HB = 104 * MiB;
constexpr size_t WS_PROJ = 168 * MiB;
constexpr size_t WS_MIX = 392 * MiB;
constexpr size_t WS_GATES = 456 * MiB;
constexpr size_t WS_LSE = 457 * MiB;
constexpr size_t WS_NCH = 459 * MiB;
constexpr size_t WS_NPREV = WS_NCH + 512 * 1024;
constexpr size_t WS_SC = 460 * MiB;
constexpr size_t WS_GS = 460 * MiB + 65536;
constexpr size_t WS_KC = 462 * MiB;
constexpr size_t WS_END = 494 * MiB;
constexpr size_t DO_ATT = 0, DO_CPT = 96 * MiB;
constexpr int CW_BAR = 4096;
constexpr int CW_ROWSS = 65536;
static_assert((CW_ROWSS + T) * 4 <= (int)CTL_ZERO_BYTES && CW_BAR + 16 * 3456 <= CW_ROWSS, "CTL words inside the memset region");

constexpr int RING_BYTES = 131072;
constexpr int SM_OFF = 135168;
constexpr int LDSCTL_OFF = 143360, MISC_OFF = LDSCTL_OFF + 320;
constexpr int LDS_BYTES = 147456;
static_assert(MISC_OFF + 128 <= LDS_BYTES, "LDS map");

#define GAS __attribute__((address_space(1)))
#define LAS __attribute__((address_space(3)))
typedef unsigned short bf16;
typedef unsigned v4u __attribute__((ext_vector_type(4)));
typedef unsigned v2u __attribute__((ext_vector_type(2)));
typedef float f32x4 __attribute__((ext_vector_type(4)));
typedef short bf16x8 __attribute__((ext_vector_type(8)));
typedef short s16x4 __attribute__((ext_vector_type(4)));
typedef GAS unsigned gu32;
#define RLX_AGENT __ATOMIC_RELAXED, __HIP_MEMORY_SCOPE_AGENT
#define LDS_WAIT() asm volatile("s_waitcnt lgkmcnt(0)" ::: "memory")
#define VM_WAIT() asm volatile("s_waitcnt vmcnt(0)" ::: "memory")
#define LBAR() do { asm volatile("s_waitcnt lgkmcnt(0)" ::: "memory"); __builtin_amdgcn_s_barrier(); asm volatile("" ::: "memory"); } while (0)
__device__ __forceinline__ unsigned pk2(float lo, float hi) { return pg8::cvt_pk_bf16(lo, hi); }
__device__ __forceinline__ float bf_lo(unsigned u) { return __uint_as_float(u << 16); }
__device__ __forceinline__ float bf_hi(unsigned u) { return __uint_as_float(u & 0xffff0000u); }
__device__ __forceinline__ void unpack8(const v4u r, float* f) { f[0] = bf_lo(r.x); f[1] = bf_hi(r.x); f[2] = bf_lo(r.y); f[3] = bf_hi(r.y); f[4] = bf_lo(r.z); f[5] = bf_hi(r.z); f[6] = bf_lo(r.w); f[7] = bf_hi(r.w); }
__device__ __forceinline__ v4u pack8(const float* f) { v4u r; r.x = pk2(f[0], f[1]); r.y = pk2(f[2], f[3]); r.z = pk2(f[4], f[5]); r.w = pk2(f[6], f[7]); return r; }
__device__ __forceinline__ f32x4 mfma16(bf16x8 a, bf16x8 b, f32x4 c) { return __builtin_amdgcn_mfma_f32_16x16x32_bf16(a, b, c, 0, 0, 0); }
__device__ __forceinline__ s16x4 tr_read(LAS unsigned char* p) { return __builtin_amdgcn_ds_read_tr16_b64_v4i16((LAS s16x4*)p); }
__device__ __forceinline__ bf16x8 cat44(s16x4 lo, s16x4 hi) { return __builtin_shufflevector(lo, hi, 0, 1, 2, 3, 4, 5, 6, 7); }
__device__ __forceinline__ float siluf(float y) { return y * __builtin_amdgcn_rcpf(1.0f + __expf(-y)); }
__device__ __forceinline__ float sigmf(float y) { return __builtin_amdgcn_rcpf(1.0f + __expf(-y)); }
__device__ __forceinline__ const bf16* seg_ptr(const bf16* proj, int seg, int h) { return proj + (size_t)(seg * NH + h) * T * HD; }
__device__ __forceinline__ int kimg(int r, int ch) { return r * 256 + ((ch ^ (r & 15)) << 4); }
__device__ __forceinline__ int vimg(int r, int ch) { return r * 256 + ((ch ^ ((r & 7) << 1)) << 4); }
#define XB_TMO      128
#define XB_XCNT(j)  (256  + 64 * (j))
#define XB_XSUB(j)  (1280 + 64 * (j))
#define XB_XGEN(j)  (2304 + 64 * (j))
#define XB_TOP      3328
#define XB_TOPGEN   3392
#define XCD_BAR_WORDS 3456
#define XB_SPIN_CAP (1u << 18)

__device__ __forceinline__ unsigned xb_ld(unsigned* p)              { return __hip_atomic_load(p, __ATOMIC_RELAXED, __HIP_MEMORY_SCOPE_AGENT); }
__device__ __forceinline__ unsigned xb_add(unsigned* p, unsigned v) { return __hip_atomic_fetch_add(p, v, __ATOMIC_RELAXED, __HIP_MEMORY_SCOPE_AGENT); }
__device__ __forceinline__ unsigned xb_xcc_id() { return (unsigned)__builtin_amdgcn_s_getreg((3 << 11) | 20) & 0xFu; }
#define XB_SPIN(cond, bar) do { unsigned _sp = 0; while (cond) { __builtin_amdgcn_s_sleep(1); \
    if ((++_sp & 255u) == 0u) { if (xb_ld(&(bar)[XB_TMO])) break; if (_sp > XB_SPIN_CAP) { atomicAdd(&(bar)[XB_TMO], 1u); break; } } } } while (0)

struct XcdBarrier {
    unsigned* bar; unsigned x;
    volatile LAS unsigned* st;
};

__device__ __forceinline__ XcdBarrier xcd_barrier_post(unsigned* bar, volatile LAS unsigned* st) {
    XcdBarrier b; b.bar = bar; b.x = xb_xcc_id(); b.st = st;
    if (threadIdx.x == 0) (void)xb_add(&bar[XB_XCNT(b.x)], 1u);
    return b;
}
__device__ __forceinline__ void xcd_barrier_complete(unsigned* bar, unsigned x, unsigned& nloc, unsigned& nx) {
    const unsigned G = gridDim.x * gridDim.y * gridDim.z;
    unsigned sum, cnt, mine, sp = 0u;
    for (;;) {
        sum = 0u; cnt = 0u; mine = 0u;
#pragma unroll
        for (unsigned j = 0; j < 16; ++j) { const unsigned c = xb_ld(&bar[XB_XCNT(j)]); sum += c; cnt += (c > 0u) ? 1u : 0u; mine = (j == x) ? c : mine; }
        if (sum == G) break;
        __builtin_amdgcn_s_sleep(1);
        if ((++sp & 255u) == 0u) { if (xb_ld(&bar[XB_TMO])) break; if (sp > XB_SPIN_CAP) { atomicAdd(&bar[XB_TMO], 1u); break; } }
    }
    nloc = mine > 0u ? mine : 1u; nx = cnt > 0u ? cnt : 1u;
}

__device__ __forceinline__ void xcd_barrier(const XcdBarrier& b) {
    asm volatile("s_waitcnt vmcnt(0)" ::: "memory");
    __syncthreads();
    if (threadIdx.x == 0) {
        unsigned* bar = b.bar;
        __builtin_amdgcn_s_waitcnt(0);
        unsigned nloc = b.st[0], nx = b.st[1];
        if (nloc == 0u) { xcd_barrier_complete(bar, b.x, nloc, nx); b.st[0] = nloc; b.st[1] = nx; }
        const unsigned old = xb_add(&bar[XB_XSUB(b.x)], 1u);
        const unsigned gen = old / nloc;
        if (old + 1u == (gen + 1u) * nloc) {
            __builtin_amdgcn_fence(__ATOMIC_RELEASE, "agent");
            asm volatile("s_waitcnt vmcnt(0)" ::: "memory");
            const unsigned og = xb_add(&bar[XB_TOP], 1u);
            const unsigned tg = og / nx;
            if (og + 1u == (tg + 1u) * nx) xb_add(&bar[XB_TOPGEN], 1u);
            else XB_SPIN(xb_ld(&bar[XB_TOPGEN]) == tg, bar);
            __builtin_amdgcn_fence(__ATOMIC_ACQUIRE, "agent");
            xb_add(&bar[XB_XGEN(b.x)], 1u);
            asm volatile("s_waitcnt vmcnt(0)" ::: "memory");
        } else {
            XB_SPIN(xb_ld(&bar[XB_XGEN(b.x)]) == gen, bar);
            __builtin_amdgcn_fence(__ATOMIC_ACQUIRE, "agent");
            asm volatile("s_waitcnt vmcnt(0)" ::: "memory");
        }
    }
    __syncthreads();
}

__device__ __forceinline__ float wave_sum(float v) {
#pragma unroll
    for (int o = 1; o < 64; o <<= 1) v += __shfl_xor(v, o);
    return v;
}
struct TItem { const float* W; const float* ksc; bf16* WT; int ldw, K, mode, k0, n0; };
__device__ __forceinline__ void p0_load(const TItem& t, f32x4 (&v)[8], int lane) {
    const float* p = t.W + (size_t)(t.k0 + (lane >> 3)) * t.ldw + t.n0 + 4 * (lane & 7);
#pragma unroll
    for (int i = 0; i < 8; ++i) v[i] = __builtin_nontemporal_load((const f32x4*)(p + (size_t)(8 * i) * t.ldw));
}
__device__ __forceinline__ void p0_emit(const TItem& t, const f32x4 (&v)[8], LAS float* scr, int lane) {
#pragma unroll
    for (int i = 0; i < 8; ++i) { const int kk = 8 * i + (lane >> 3); f32x4 y = v[i]; if (t.ksc) y = y * t.ksc[t.k0 + kk];
        LAS float* d = scr + kk * 33 + 4 * (lane & 7); d[0] = y.x; d[1] = y.y; d[2] = y.z; d[3] = y.w; }
    LDS_WAIT(); asm volatile("" ::: "memory");
    const int c = lane & 7;
    int nbase = t.n0; if (t.mode) nbase = ((t.n0 >> 7) << 8) + (t.n0 & 127) + (t.mode == 2 ? 128 : 0);
#pragma unroll
    for (int j = 0; j < 4; ++j) { const int n = (lane >> 3) + 8 * j; const LAS float* s = scr + (8 * c) * 33 + n;
        v4u o; o.x = pk2(s[0 * 33], s[1 * 33]); o.y = pk2(s[2 * 33], s[3 * 33]); o.z = pk2(s[4 * 33], s[5 * 33]); o.w = pk2(s[6 * 33], s[7 * 33]);
        *(GAS v4u*)(t.WT + (size_t)(nbase + n) * t.K + t.k0 + 8 * c) = o; }
    LDS_WAIT(); asm volatile("" ::: "memory");
}
constexpr int P0_SCR = 8448, P0_WG = 69632;
__device__ __forceinline__ int wgimg(int gate, int c) { return P0_WG + gate * 4096 + ((c ^ gate) << 4); }
template <int PARTS> __device__ __forceinline__ void p0_prologue(LAS unsigned char* lds, LAS float* sm, const float* const* in, unsigned char* ws, int vcu, int G, int tid, int lane, int wave) {
    const float* w_in = in[2]; const float* w_out = in[9]; const float* nfg = in[10]; const float* w_gate = in[11]; const float* w_up = in[12]; const float* w_down = in[13];
    {   float f[8][8];
#pragma unroll
        for (int i = 0; i < 8; ++i) { const int pr = tid + i * NWAVES * 64, gate = pr & 15, c = pr >> 4;
#pragma unroll
            for (int j = 0; j < 8; ++j) f[i][j] = w_in[(size_t)(8 * c + j) * INW + PJ + gate]; }
#pragma unroll
        for (int i = 0; i < 8; ++i) { const int pr = tid + i * NWAVES * 64, gate = pr & 15, c = pr >> 4; *(LAS v4u*)(lds + wgimg(gate, c)) = pack8(f[i]); }
    }
    LAS float* scr = (LAS float*)(lds + wave * P0_SCR);
    const int gw = vcu * NWAVES + wave, NGW = G * NWAVES;
    bf16* WIN = (bf16*)(ws + WS_WIN); bf16* WOUT = (bf16*)(ws + WS_WOUT); bf16* WGU = (bf16*)(ws + WS_WGU); bf16* WDN = (bf16*)(ws + WS_WDN);
    constexpr int I_IN = (DM / 64) * (PJ / 32), I_OUT = (DM / 64) * (DM / 32), I_G = (DM / 64) * (FF / 32), I_D = (FF / 64) * (DM / 32);
    constexpr int NITEMS = I_IN + I_OUT + 2 * I_G + I_D;
    auto decode = [&](int it) -> TItem {
        TItem t; int r = it, nblk;
        if (r < I_IN) { t.W = w_in; t.ldw = INW; nblk = PJ / 32; t.K = DM; t.WT = WIN; t.ksc = nullptr; t.mode = 0; }
        else if ((r -= I_IN) < I_OUT) { t.W = w_out; t.ldw = DM; nblk = DM / 32; t.K = DM; t.WT = WOUT; t.ksc = nullptr; t.mode = 0; }
        else if ((r -= I_OUT) < I_G) { t.W = w_gate; t.ldw = FF; nblk = FF / 32; t.K = DM; t.WT = WGU; t.ksc = nfg; t.mode = 1; }
        else if ((r -= I_G) < I_G) { t.W = w_up; t.ldw = FF; nblk = FF / 32; t.K = DM; t.WT = WGU; t.ksc = nfg; t.mode = 2; }
        else { r -= I_G; t.W = w_down; t.ldw = DM; nblk = DM / 32; t.K = FF; t.WT = WDN; t.ksc = nullptr; t.mode = 0; }
        const int kb = r / nblk; t.k0 = 64 * kb; t.n0 = 32 * (r - kb * nblk); return t; };
    if (PARTS & 1) {
        int it = gw; f32x4 va[8], vb[8]; TItem ta, tb;
        if (it < NITEMS) { ta = decode(it); p0_load(ta, va, lane); }
        while (it < NITEMS) {
            int itn = it + NGW; if (itn < NITEMS) { tb = decode(itn); p0_load(tb, vb, lane); }
            p0_emit(ta, va, scr, lane);
            it = itn; if (it >= NITEMS) break;
            itn = it + NGW; if (itn < NITEMS) { ta = decode(itn); p0_load(ta, va, lane); }
            p0_emit(tb, vb, scr, lane);
            it = itn;
        }
    }
    const float* x = in[0]; const float* nmg = in[1]; const float* gate_b = in[5];
    bf16* HB = (bf16*)(ws + WS_HB); float* GATES = (float*)(ws + WS_GATES);
    f32x4 gn[8];
#pragma unroll
    for (int j = 0; j < 8; ++j) gn[j] = *((const f32x4*)nmg + lane + 64 * j);
    if (PARTS & 2) for (int rg = vcu; rg < T / 64; rg += G) {
        const int m0 = rg * 64 + 8 * wave;
        f32x4 nv[8];
        { const GAS f32x4* xr = (const GAS f32x4*)(x + (size_t)m0 * DM) + lane;
#pragma unroll
          for (int j = 0; j < 8; ++j) nv[j] = __builtin_nontemporal_load(xr + 64 * j); }
#pragma unroll 1
        for (int i = 0; i < 8; ++i) {
            f32x4 v[8]; float s = 0.f;
#pragma unroll
            for (int j = 0; j < 8; ++j) { v[j] = nv[j]; s += (v[j].x * v[j].x + v[j].y * v[j].y) + (v[j].z * v[j].z + v[j].w * v[j].w); }
            if (i < 7) { const GAS f32x4* xr = (const GAS f32x4*)(x + (size_t)(m0 + i + 1) * DM) + lane;
#pragma unroll
                for (int j = 0; j < 8; ++j) nv[j] = __builtin_nontemporal_load(xr + 64 * j); }
            const float rstd = 1.0f / sqrtf(wave_sum(s) * (1.f / DM) + EPS);
            GAS unsigned long long* o8 = (GAS unsigned long long*)(HB + (size_t)(m0 + i) * DM) + lane;
#pragma unroll
            for (int j = 0; j < 8; ++j) { const f32x4 y = v[j] * rstd * gn[j]; o8[64 * j] = (unsigned long long)pk2(y.x, y.y) | ((unsigned long long)pk2(y.z, y.w) << 32); }
        }
        VM_WAIT(); __syncthreads();
        {
            const int x16 = lane & 15, g = lane >> 4, q = wave >> 1, kh = wave & 1;
            const bf16* hp = HB + (size_t)(rg * 64 + 16 * q + x16) * DM + 1024 * kh + 8 * g;
            f32x4 acc = (f32x4){0.f, 0.f, 0.f, 0.f};
#pragma unroll 8
            for (int s = 0; s < 32; ++s) {
                const bf16x8 bq = __builtin_bit_cast(bf16x8, *(const v4u*)(hp + 32 * s));
                const bf16x8 a = *(const LAS bf16x8*)(lds + wgimg(x16, 128 * kh + 4 * s + g));
                acc = mfma16(a, bq, acc);
            }
            if (kh) *(LAS f32x4*)(sm + (q * 64 + lane) * 4) = acc;
            __syncthreads();
            if (!kh) { const f32x4 o = *(const LAS f32x4*)(sm + (q * 64 + lane) * 4); const f32x4 gb = *(const f32x4*)(gate_b + 4 * g);
                *(f32x4*)(GATES + (size_t)(rg * 64 + 16 * q + x16) * 16 + 4 * g) = acc + o + gb; }
            __syncthreads();
        }
    }
}

struct AttnP { int b, h, dil, gi, r, n; };
__device__ __forceinline__ AttnP attn_decode(int L) {
    const int xc = (L & 255) >> 5, jj = L & 31, ii = L >> 8, qx = jj + 32 * ii;
    const int bh = 4 * xc + qx / 96, rem = qx % 96, gi = rem >> 5, i32 = rem & 31, sh = 2 * gi;
    AttnP p; p.gi = gi; p.dil = 1 << sh; p.b = bh >> 3; p.h = bh & 7; p.r = i32 & (p.dil - 1); p.n = i32 >> sh; return p;
}
__device__ __forceinline__ void attn_prefetch_k(const bf16* proj, const AttnP& p, int tid, v4u (&kr)[8]) {
    const unsigned vo = (unsigned)((tid >> 4) * p.dil * HD + (tid & 15) * 8) * 2u;
#pragma unroll
    for (int it = 0; it < 8; ++it) {
        const int ci = 128 * (p.n - 1) + it * 32 + ((p.n == 0 && it < 4) ? 128 : 0);
        const char* sb = (const char*)(seg_ptr(proj, S_AK, p.h) + ((size_t)p.b * SEQ + (size_t)ci * p.dil + p.r) * HD);
        kr[it] = *(const v4u*)(sb + vo);
    }
}
__device__ __forceinline__ void attn_load_q(const bf16* proj, const AttnP& p, int lane, int w, v4u (&qr)[4]) {
    const char* qb = (const char*)(seg_ptr(proj, S_AQ, p.h) + ((size_t)p.b * SEQ + (size_t)(128 * p.n + 16 * w) * p.dil + p.r) * HD);
    const unsigned qo = (unsigned)((lane & 15) * p.dil * HD + 8 * (lane >> 4)) * 2u;
#pragma unroll
    for (int s = 0; s < 4; ++s) qr[s] = *(const v4u*)(qb + qo + 64 * s);
}
__device__ __forceinline__ void attn_prefetch_v(const bf16* proj, const AttnP& p, int tid, v4u (&vr)[8]) {
    const unsigned vo = (unsigned)((tid >> 4) * p.dil * HD + (tid & 15) * 8) * 2u;
#pragma unroll
    for (int it = 0; it < 8; ++it) {
        const int ci = 128 * (p.n - 1) + it * 32 + ((p.n == 0 && it < 4) ? 128 : 0);
        const char* sb = (const char*)(seg_ptr(proj, S_AV, p.h) + ((size_t)p.b * SEQ + (size_t)ci * p.dil + p.r) * HD);
        vr[it] = *(const v4u*)(sb + vo);
    }
}
__device__ __forceinline__ void attn_stage(LAS unsigned char* lds, const AttnP& p, int tid, const v4u (&kr)[8], const v4u (&vr)[8], const v4u (&qr)[4], bf16x8 (&qf)[4]) {
    const int ch = tid & 15;
#pragma unroll
    for (int it = 0; it < 8; ++it) {
        const int row = it * 32 + (tid >> 4); const bool ok = (128 * (p.n - 1) + row) >= 0;
        v4u ko = kr[it], vo = vr[it];
        if (!ok) { ko = (v4u){0u, 0u, 0u, 0u}; vo = (v4u){0u, 0u, 0u, 0u}; }
        *(LAS v4u*)(lds + kimg(row, ch)) = ko;
        *(LAS v4u*)(lds + 65536 + vimg(row, ch)) = vo;
    }
#pragma unroll
    for (int s = 0; s < 4; ++s) qf[s] = __builtin_bit_cast(bf16x8, qr[s]);
}
template <bool FIRST, int MODE = 0> __device__ __forceinline__ void attn_compute(LAS unsigned char* lds, const AttnP& p, const bf16x8 (&qf)[4], float cb, bf16* og, float* osum, int lane, int w) {
    const int x = lane & 15, g = lane >> 4, n = p.n, q4 = x >> 2, p2 = x & 3;
    const size_t tq = (size_t)p.b * SEQ + (size_t)(128 * n + 16 * w + x) * p.dil + p.r;
    const int start = w < 6 ? w : 6;
    int kbase[4], vbase[8];
#pragma unroll
    for (int s = 0; s < 4; ++s) kbase[s] = (start * 16 + x) * 256 + (((4 * s + g) ^ x) << 4);
#pragma unroll
    for (int eb = 0; eb < 8; ++eb) vbase[eb] = 65536 + (start * 16 + 4 * g + q4) * 256 + (((2 * eb + (p2 >> 1)) ^ (((4 * g + q4) & 7) << 1)) << 4) + 8 * (p2 & 1);
    f32x4 oacc[8];
#pragma unroll
    for (int eb = 0; eb < 8; ++eb) oacc[eb] = (f32x4){0.f, 0.f, 0.f, 0.f};
    const int qrel = 16 * w + x; float sum = 0.f;
    bf16x8 ka[2][4];
#pragma unroll
    for (int h2 = 0; h2 < 2; ++h2)
#pragma unroll
        for (int s = 0; s < 4; ++s) ka[h2][s] = *(const LAS bf16x8*)(lds + kbase[s] + h2 * 4096);
#pragma unroll
    for (int i = 0; i < 5; ++i) {
        s16x4 va[8][2];
#pragma unroll
        for (int eb = 0; eb < 8; ++eb) { va[eb][0] = tr_read(lds + vbase[eb] + i * 8192); va[eb][1] = tr_read(lds + vbase[eb] + i * 8192 + 4096); }
        f32x4 sc[2];
#pragma unroll
        for (int h2 = 0; h2 < 2; ++h2) { sc[h2] = (f32x4){0.f, 0.f, 0.f, 0.f};
#pragma unroll
            for (int s = 0; s < 4; ++s) sc[h2] = mfma16(ka[h2][s], qf[s], sc[h2]); }
        if (i < 4) {
#pragma unroll
            for (int h2 = 0; h2 < 2; ++h2)
#pragma unroll
                for (int s = 0; s < 4; ++s) ka[h2][s] = *(const LAS bf16x8*)(lds + kbase[s] + (2 * i + 2 + h2) * 4096);
        }
        float pe[2][4];
#pragma unroll
        for (int h2 = 0; h2 < 2; ++h2)
#pragma unroll
            for (int q = 0; q < 4; ++q) {
                float e = __builtin_amdgcn_exp2f(sc[h2][q] - cb);
                if (FIRST || i == 0 || i == 4) { const int kr = (start + 2 * i + h2) * 16 + 4 * g + q - 128, dist = qrel - kr; const bool valid = (dist >= 0) && (dist <= 128) && (!FIRST || kr >= 0); e = valid ? e : 0.f; }
                pe[h2][q] = e; sum += e; }
        v4u pw; pw.x = pk2(pe[0][0], pe[0][1]); pw.y = pk2(pe[0][2], pe[0][3]); pw.z = pk2(pe[1][0], pe[1][1]); pw.w = pk2(pe[1][2], pe[1][3]);
        const bf16x8 pf = __builtin_bit_cast(bf16x8, pw);
#pragma unroll
        for (int eb = 0; eb < 8; ++eb) oacc[eb] = mfma16(cat44(va[eb][0], va[eb][1]), pf, oacc[eb]);
    }
    sum += __shfl_xor(sum, 16); sum += __shfl_xor(sum, 32);
    const float inv = 1.0f / sum;
    bf16* op = og + ((size_t)(p.gi * NH + p.h) * T + tq) * HD + 4 * g;
#pragma unroll
    for (int eb = 0; eb < 8; ++eb) { v2u o; o.x = pk2(oacc[eb][0] * inv, oacc[eb][1] * inv); o.y = pk2(oacc[eb][2] * inv, oacc[eb][3] * inv); if (MODE == 0) *(v2u*)(op + 16 * eb) = o; else asm volatile("" :: "v"(o.x), "v"(o.y)); }
    if (MODE == 0) { if (g == 0) osum[(size_t)(p.gi * NH + p.h) * T + tq] = sum; }
}
template <int MODE = 0> __device__ __forceinline__ void attn_phase(LAS unsigned char* lds, const bf16* proj, bf16* og, float* osum, const float* __restrict__ qg, const float* __restrict__ kg, int vcu, int G, int tid, int lane, int w) {
    int L = vcu; if (L >= 3072) return;
    float cb;
    { float mq = fmaxf(fabsf(qg[lane]), fabsf(qg[lane + 64])), mk = fmaxf(fabsf(kg[lane]), fabsf(kg[lane + 64]));
#pragma unroll
      for (int o = 32; o >= 1; o >>= 1) { mq = fmaxf(mq, __shfl_xor(mq, o)); mk = fmaxf(mk, __shfl_xor(mk, o)); }
      cb = 11.313708499f * mq * mk * LOG2E; }
    AttnP p = attn_decode(L);
    v4u kr[8], vr[8], qr[4];
    attn_prefetch_k(proj, p, tid, kr); attn_prefetch_v(proj, p, tid, vr); attn_load_q(proj, p, lane, w, qr);
    for (;;) {
        bf16x8 qf[4];
        attn_stage(lds, p, tid, kr, vr, qr, qf);
        LBAR();
        const int Ln = L + G; const bool more = Ln < 3072;
        const AttnP pn = attn_decode(more ? Ln : L);
        if (MODE != 2) { attn_prefetch_k(proj, pn, tid, kr); attn_prefetch_v(proj, pn, tid, vr); attn_load_q(proj, pn, lane, w, qr); }
        if (MODE != 1) { if (p.n == 0) attn_compute<true, MODE>(lds, p, qf, cb, og, osum, lane, w); else attn_compute<false, MODE>(lds, p, qf, cb, og, osum, lane, w); }
        LBAR();
        if (!more) break;
        p = pn; L = Ln;
    }
}

__device__ __forceinline__ void gate_prepass(const float* gates, float* gs, float* sc, int idx, int lane) {
    const int c = idx & 31, bh = idx >> 5, h = bh & 7, b = bh >> 3;
    const size_t t0 = (size_t)b * SEQ + 128 * c;
    const float* g0 = gates + (t0 + lane) * 16, * g1 = gates + (t0 + 64 + lane) * 16;
    const float i0 = g0[h], f0 = g0[8 + h], i1 = g1[h], f1 = g1[8 + h];
    float v0 = fminf(f0, 0.f) - log1pf(expf(-fabsf(f0))), v1 = fminf(f1, 0.f) - log1pf(expf(-fabsf(f1)));
#pragma unroll
    for (int o = 1; o < 64; o <<= 1) { const float a0 = __shfl_up(v0, o), a1 = __shfl_up(v1, o); if (lane >= o) { v0 += a0; v1 += a1; } }
    v1 += __shfl(v0, 63);
    const float u0 = i0 - v0, u1 = i1 - v1;
    float m = fmaxf(u0, u1);
#pragma unroll
    for (int o = 32; o >= 1; o >>= 1) m = fmaxf(m, __shfl_xor(m, o));
    float* gp = gs + (size_t)idx * 256;
    gp[lane] = v0; gp[64 + lane] = v1; gp[128 + lane] = u0; gp[192 + lane] = u1;
    if (lane == 63) { sc[idx] = v1; sc[1024 + idx] = v1 + m; sc[3072 + idx] = m; }
}
__device__ __forceinline__ void load_conv_w(const float* __restrict__ convw, const float* __restrict__ convb, int cc, float (&cw)[4][8], float (&cb)[8]) {
#pragma unroll
    for (int tap = 0; tap < 4; ++tap) { const f32x4 a = *(const f32x4*)(convw + tap * 2048 + cc), c = *(const f32x4*)(convw + tap * 2048 + cc + 4);
        cw[tap][0] = a.x; cw[tap][1] = a.y; cw[tap][2] = a.z; cw[tap][3] = a.w; cw[tap][4] = c.x; cw[tap][5] = c.y; cw[tap][6] = c.z; cw[tap][7] = c.w; }
    const f32x4 a = *(const f32x4*)(convb + cc), c = *(const f32x4*)(convb + cc + 4);
    cb[0] = a.x; cb[1] = a.y; cb[2] = a.z; cb[3] = a.w; cb[4] = c.x; cb[5] = c.y; cb[6] = c.z; cb[7] = c.w;
}
__device__ __forceinline__ void stage_conv_w(LAS float* sm, const float* __restrict__ convw, const float* __restrict__ convb, int h, int tid) {
    for (int i = tid; i < 1280; i += NWAVES * 64) { const int path = i / 640, r = i - path * 640, tap = r >> 7, d = r & 127, cc = (path == 0 ? 1024 : 0) + h * 128 + d;
        sm[i] = tap < 4 ? convw[tap * 2048 + cc] : convb[cc]; }
}
__device__ __forceinline__ void load_conv_w_lds(const LAS float* sm, int path, int ch, float (&cw)[4][8], float (&cb)[8]) {
#pragma unroll
    for (int tap = 0; tap < 4; ++tap) { const f32x4 a = *(const LAS f32x4*)(sm + path * 640 + tap * 128 + ch * 8), c = *(const LAS f32x4*)(sm + path * 640 + tap * 128 + ch * 8 + 4);
        cw[tap][0] = a.x; cw[tap][1] = a.y; cw[tap][2] = a.z; cw[tap][3] = a.w; cw[tap][4] = c.x; cw[tap][5] = c.y; cw[tap][6] = c.z; cw[tap][7] = c.w; }
    const f32x4 a = *(const LAS f32x4*)(sm + path * 640 + 512 + ch * 8), c = *(const LAS f32x4*)(sm + path * 640 + 512 + ch * 8 + 4);
    cb[0] = a.x; cb[1] = a.y; cb[2] = a.z; cb[3] = a.w; cb[4] = c.x; cb[5] = c.y; cb[6] = c.z; cb[7] = c.w;
}
__device__ __forceinline__ void conv4x8(const v4u (&raw)[7], const float (&cw)[4][8], const float (&cb)[8], float (&y)[4][8]) {
#pragma unroll
    for (int i = 0; i < 4; ++i)
#pragma unroll
        for (int j = 0; j < 8; ++j) y[i][j] = cb[j];
#pragma unroll
    for (int r = 0; r < 7; ++r) { float f[8]; unpack8(raw[r], f);
#pragma unroll
        for (int i = 0; i < 4; ++i) { const int tap = r - i; if (tap >= 0 && tap < 4) {
#pragma unroll
            for (int j = 0; j < 8; ++j) y[i][j] += f[j] * cw[tap][j]; } } }
#pragma unroll
    for (int i = 0; i < 4; ++i)
#pragma unroll
        for (int j = 0; j < 8; ++j) y[i][j] = siluf(y[i][j]);
}

struct MARegs { v4u kraw[7], qraw[7], vr[4]; f32x4 u4; float umax; };
__device__ __forceinline__ void mA_prefetch(const bf16* proj, const float* gs, const float* sc, int idx, int tid, MARegs& R) {
    const int c = idx & 31, bh = idx >> 5, h = bh & 7, b = bh >> 3, rg = tid >> 4, ch = tid & 15;
    const size_t t0 = (size_t)b * SEQ + 128 * c;
    const bf16* bk3 = seg_ptr(proj, S_MK, h) + (t0 - 3) * HD, * bq3 = seg_ptr(proj, S_MQ, h) + (t0 - 3) * HD, * bv = seg_ptr(proj, S_MV, h) + t0 * HD;
    const int lo = (c == 0) ? 3 : 0;
#pragma unroll
    for (int j = 0; j < 7; ++j) { int row3 = 4 * rg + j; row3 = row3 < lo ? lo : row3;
        const unsigned vo = (unsigned)(row3 * HD + ch * 8) * 2u;
        R.kraw[j] = *(const v4u*)((const char*)bk3 + vo); R.qraw[j] = *(const v4u*)((const char*)bq3 + vo); }
    const unsigned vo = (unsigned)(4 * rg * HD + ch * 8) * 2u;
#pragma unroll
    for (int i = 0; i < 4; ++i) R.vr[i] = *(const v4u*)((const char*)(bv + i * HD) + vo);
    R.u4 = *(const f32x4*)(gs + (size_t)idx * 256 + 128 + 4 * rg);
    R.umax = __hip_atomic_load(sc + 3072 + idx, __ATOMIC_RELAXED, __HIP_MEMORY_SCOPE_AGENT);
}
__device__ __forceinline__ void mlstmA_phase(LAS unsigned char* lds, LAS float* sm, const bf16* proj, const float* gates, const float* __restrict__ convw, const float* __restrict__ convb,
                                             bf16* kvt, float* nch, float* sc, float* gs, bf16* kc, bf16* mix, int vcu, int G, int tid, int lane, int w) {
    if (vcu >= 1024) return;
    for (int idx = vcu + G * w; idx < 1024; idx += G * NWAVES) gate_prepass(gates, gs, sc, idx, lane);
    int hcur = (vcu >> 5) & 7; stage_conv_w(sm, convw, convb, hcur, tid);
    VM_WAIT(); __syncthreads();
    int idx = vcu;
    MARegs R; mA_prefetch(proj, gs, sc, idx, tid, R);
    const int x = lane & 15, g = lane >> 4, rg = tid >> 4, ch = tid & 15;
    for (;;) {
        const int c = idx & 31, bh = idx >> 5, h = bh & 7, b = bh >> 3;
        const size_t t0 = (size_t)b * SEQ + 128 * c;
        if (h != hcur) { hcur = h; stage_conv_w(sm, convw, convb, hcur, tid); VM_WAIT(); LBAR(); }
        if (c == 0 && rg == 0) {
#pragma unroll
            for (int j = 0; j < 3; ++j) { R.kraw[j] = (v4u){0u, 0u, 0u, 0u}; R.qraw[j] = (v4u){0u, 0u, 0u, 0u}; } }
        {
            float cw[4][8], cb[8]; load_conv_w_lds(sm, 0, ch, cw, cb);
            float y[4][8]; conv4x8(R.kraw, cw, cb, y);
#pragma unroll
            for (int i = 0; i < 4; ++i) { const int l = 4 * rg + i; const float wa = __expf(R.u4[i] - R.umax);
#pragma unroll
                for (int j = 0; j < 8; ++j) y[i][j] *= RSQRT_HD;
                *(v4u*)(kc + ((size_t)h * T + t0 + l) * HD + ch * 8) = pack8(y[i]);
#pragma unroll
                for (int j = 0; j < 8; ++j) y[i][j] *= wa;
                *(LAS v4u*)(lds + vimg(l, ch)) = pack8(y[i]); }
        }
        {
            float cw[4][8], cb[8]; load_conv_w_lds(sm, 1, ch, cw, cb);
            float y[4][8]; conv4x8(R.qraw, cw, cb, y);
#pragma unroll
            for (int i = 0; i < 4; ++i) *(v4u*)(mix + (t0 + 4 * rg + i) * DM + AW + h * 128 + ch * 8) = pack8(y[i]);
        }
#pragma unroll
        for (int i = 0; i < 4; ++i) *(LAS v4u*)(lds + 32768 + vimg(4 * rg + i, ch)) = R.vr[i];
        LBAR();
        const int idn = idx + G; const bool more = idn < 1024;
        mA_prefetch(proj, gs, sc, more ? idn : idx, tid, R);
        f32x4 acc[8], accn = (f32x4){0.f, 0.f, 0.f, 0.f};
#pragma unroll
        for (int db = 0; db < 8; ++db) acc[db] = (f32x4){0.f, 0.f, 0.f, 0.f};
        const int q4 = x >> 2, p2 = x & 3;
        const int xr = ((4 * g + q4) & 7) << 1;
        const int rowb = (4 * g + q4) * 256 + 8 * (p2 & 1);
        int vbase = 32768 + rowb + (((2 * w + (p2 >> 1)) ^ xr) << 4), kb[8];
#pragma unroll
        for (int db = 0; db < 8; ++db) kb[db] = rowb + (((2 * db + (p2 >> 1)) ^ xr) << 4);
        const bf16x8 ones = (bf16x8){0x3F80, 0x3F80, 0x3F80, 0x3F80, 0x3F80, 0x3F80, 0x3F80, 0x3F80};
#pragma unroll
        for (int ks = 0; ks < 4; ++ks) {
            const bf16x8 vf = cat44(tr_read(lds + vbase + ks * 8192), tr_read(lds + vbase + ks * 8192 + 4096));
#pragma unroll
            for (int db = 0; db < 8; ++db) {
                const bf16x8 kf = cat44(tr_read(lds + kb[db] + ks * 8192), tr_read(lds + kb[db] + ks * 8192 + 4096));
                acc[db] = mfma16(kf, vf, acc[db]);
                if (db == w) accn = mfma16(kf, ones, accn);
            }
        }
        bf16* kp = kvt + (size_t)idx * 16384 + (size_t)(16 * w + x) * 128 + 4 * g;
#pragma unroll
        for (int db = 0; db < 8; ++db) { v2u o; o.x = pk2(acc[db][0], acc[db][1]); o.y = pk2(acc[db][2], acc[db][3]); *(v2u*)(kp + 16 * db) = o; }
        if (x == 0) *(f32x4*)(nch + (size_t)idx * 128 + 16 * w + 4 * g) = accn;
        LBAR();
        if (!more) break;
        idx = idn;
    }
}

__device__ __forceinline__ void p3_scan_merge(const bf16* kvt, const float* nch, float* sc, bf16* cpt, float* nprev, const bf16* og, const float* lse, bf16* mix, int vcu, int G, int tid) {
    const int gid = vcu * (NWAVES * 64) + tid, NT = G * NWAVES * 64;
    for (int task = gid; task < 32 * 2048; task += NT) {
        const int bh = task >> 11, f8 = task & 2047;
        float C[8]; float m = -1e30f;
#pragma unroll
        for (int j = 0; j < 8; ++j) C[j] = 0.f;
        for (int c = 0; c < 32; ++c) {
            const int idx = bh * 32 + c; const float bl = sc[idx], mc = sc[1024 + idx];
            *(v4u*)(cpt + (size_t)idx * 16384 + 8 * f8) = pack8(C);
            if (f8 == 0) sc[2048 + idx] = m;
            const float mn = fmaxf(bl + m, mc), decay = expf(bl + m - mn), scale = expf(mc - mn);
            float kv[8]; unpack8(__builtin_nontemporal_load((const v4u*)(kvt + (size_t)idx * 16384 + 8 * f8)), kv);
#pragma unroll
            for (int j = 0; j < 8; ++j) C[j] = C[j] * decay + kv[j] * scale;
            m = mn;
        }
    }
    for (int task = gid; task < 32 * 32; task += NT) {
        const int bh = task >> 5, f4 = task & 31;
        f32x4 C = (f32x4){0.f, 0.f, 0.f, 0.f}; float m = -1e30f;
        for (int c = 0; c < 32; ++c) {
            const int idx = bh * 32 + c; const float bl = sc[idx], mc = sc[1024 + idx];
            *(f32x4*)(nprev + (size_t)idx * 128 + 4 * f4) = C;
            const float mn = fmaxf(bl + m, mc), decay = expf(bl + m - mn), scale = expf(mc - mn);
            const f32x4 kv = *(const f32x4*)(nch + (size_t)idx * 128 + 4 * f4);
            C = C * decay + kv * scale; m = mn;
        }
    }
    for (int task = gid; task < T * NH * 16; task += NT) {
        const int t = task >> 7, rem = task & 127, h = rem >> 4, ch = rem & 15;
        float w0 = lse[(size_t)h * T + t], w1 = lse[(size_t)(NH + h) * T + t], w2 = lse[(size_t)(2 * NH + h) * T + t];
        const float inv = 1.0f / (w0 + w1 + w2); w0 *= inv; w1 *= inv; w2 *= inv;
        const size_t o = ((size_t)h * T + t) * HD + ch * 8;
        float a[8], bq[8], cq[8]; unpack8(__builtin_nontemporal_load((const v4u*)(og + o)), a); unpack8(__builtin_nontemporal_load((const v4u*)(og + (size_t)NH * T * HD + o)), bq); unpack8(__builtin_nontemporal_load((const v4u*)(og + (size_t)2 * NH * T * HD + o)), cq);
#pragma unroll
        for (int j = 0; j < 8; ++j) a[j] = a[j] * w0 + bq[j] * w1 + cq[j] * w2;
        *(v4u*)(mix + (size_t)t * DM + h * 128 + ch * 8) = pack8(a);
    }
}

struct MCRegs { v4u kr[4], vr[4], qr[4], cr[4]; float u[4], bq, npv, mprev, umax; };
__device__ __forceinline__ void mC_prefetch(const bf16* proj, const float* gs, const bf16* kc, const bf16* mix, const bf16* cpt, const float* nprev, const float* sc, int idx, int tid, int lane, int w, MCRegs& R) {
    const int c = idx & 31, bh = idx >> 5, h = bh & 7, b = bh >> 3, rg = tid >> 4, ch = tid & 15;
    const size_t t0 = (size_t)b * SEQ + 128 * c;
    const unsigned vk = (unsigned)(rg * HD + ch * 8) * 2u, vq = (unsigned)(rg * DM + ch * 8) * 2u;
#pragma unroll
    for (int it = 0; it < 4; ++it) {
        R.kr[it] = __builtin_nontemporal_load((const v4u*)((const char*)(kc + ((size_t)h * T + t0 + 32 * it) * HD) + vk));
        R.vr[it] = __builtin_nontemporal_load((const v4u*)((const char*)(seg_ptr(proj, S_MV, h) + (t0 + 32 * it) * HD) + vk));
        R.qr[it] = __builtin_nontemporal_load((const v4u*)((const char*)(mix + (t0 + 32 * it) * DM + AW + h * 128) + vq));
        R.cr[it] = __builtin_nontemporal_load((const v4u*)((const char*)(cpt + (size_t)idx * 16384 + 32 * it * 128) + vk));
        R.u[it] = gs[(size_t)idx * 256 + 128 + 32 * it + rg];
    }
    R.bq = gs[(size_t)idx * 256 + 16 * w + (lane & 15)];
    R.npv = 0.f; if (tid < 128) R.npv = nprev[(size_t)idx * 128 + tid];
    R.mprev = __hip_atomic_load(sc + 2048 + idx, __ATOMIC_RELAXED, __HIP_MEMORY_SCOPE_AGENT);
    R.umax = __hip_atomic_load(sc + 3072 + idx, __ATOMIC_RELAXED, __HIP_MEMORY_SCOPE_AGENT);
}
template <int MODE = 0> __device__ __forceinline__ void mlstmC_phase(LAS unsigned char* lds, LAS float* sm, const bf16* proj, const float* gs, const bf16* kc, const bf16* cpt, const float* nprev, const float* sc,
                                             const float* __restrict__ ng, bf16* mix, int vcu, int G, int tid, int lane, int w) {
    int idx = vcu; if (idx >= 1024) return;
    int hcur = (vcu >> 5) & 7; if (tid < 128) sm[640 + tid] = ng[hcur * 128 + tid];
    MCRegs R; mC_prefetch(proj, gs, kc, mix, cpt, nprev, sc, idx, tid, lane, w, R);
    const int x = lane & 15, g = lane >> 4, rg = tid >> 4, ch = tid & 15;
    for (;;) {
        const int c = idx & 31, bh = idx >> 5, h = bh & 7, b = bh >> 3;
        const size_t t0 = (size_t)b * SEQ + 128 * c;
        if (h != hcur) { hcur = h; LBAR(); if (tid < 128) sm[640 + tid] = ng[hcur * 128 + tid]; }
        const float mprev = R.mprev, M = fmaxf(mprev, R.umax), cs = __expf(mprev - M), fl = __expf(-(R.bq + M));
#pragma unroll
        for (int it = 0; it < 4; ++it) {
            const int l = it * 32 + rg;
            const float cf = __expf(R.u[it] - M);
            float y[8]; unpack8(R.kr[it], y);
#pragma unroll
            for (int j = 0; j < 8; ++j) y[j] *= cf;
            *(LAS v4u*)(lds + kimg(l, ch)) = pack8(y);
            *(LAS v4u*)(lds + 32768 + vimg(l, ch)) = R.vr[it];
            *(LAS v4u*)(lds + 65536 + kimg(l, ch)) = R.cr[it];
            *(LAS v4u*)(lds + 98304 + kimg(l, ch)) = R.qr[it];
        }
        if (tid < 128) sm[512 + tid] = R.npv;
        LBAR();
        const int idn = idx + G; const bool more = idn < 1024;
        if (MODE != 2) mC_prefetch(proj, gs, kc, mix, cpt, nprev, sc, more ? idn : idx, tid, lane, w, R);
        if (MODE == 1) { LBAR(); if (!more) break; idx = idn; continue; }
        const int lq = 16 * w + x;
        v2u mor[8];
        const int q4 = x >> 2, p2 = x & 3;
        int rb[4];
#pragma unroll
        for (int s = 0; s < 4; ++s) rb[s] = x * 256 + (((4 * s + g) ^ x) << 4);
        bf16x8 qf[4]; float qn = 0.f;
#pragma unroll
        for (int s = 0; s < 4; ++s) {
            qf[s] = *(const LAS bf16x8*)(lds + 98304 + w * 4096 + rb[s]);
            float y[8]; unpack8(__builtin_bit_cast(v4u, qf[s]), y);
#pragma unroll
            for (int j = 0; j < 8; ++j) qn += y[j] * sm[512 + 32 * s + 8 * g + j];
        }
        qn += __shfl_xor(qn, 16); qn += __shfl_xor(qn, 32);
        f32x4 acc[8];
#pragma unroll
        for (int eb = 0; eb < 8; ++eb) acc[eb] = (f32x4){0.f, 0.f, 0.f, 0.f};
#pragma unroll
        for (int s = 0; s < 4; ++s)
#pragma unroll
            for (int hf = 0; hf < 2; ++hf) {
                bf16x8 ca[4];
#pragma unroll
                for (int e4 = 0; e4 < 4; ++e4) ca[e4] = *(const LAS bf16x8*)(lds + 65536 + (4 * hf + e4) * 4096 + rb[s]);
#pragma unroll
                for (int e4 = 0; e4 < 4; ++e4) acc[4 * hf + e4] = mfma16(ca[e4], qf[s], acc[4 * hf + e4]);
            }
#pragma unroll
        for (int eb = 0; eb < 8; ++eb) acc[eb] = acc[eb] * cs;
        const int xr = ((4 * g + q4) & 7) << 1;
        int vb[8];
#pragma unroll
        for (int eb = 0; eb < 8; ++eb) vb[eb] = 32768 + (4 * g + q4) * 256 + 8 * (p2 & 1) + (((2 * eb + (p2 >> 1)) ^ xr) << 4);
        float dsum = 0.f;
        {
            const bf16* mo = seg_ptr(proj, S_MO, h) + (t0 + lq) * HD + 4 * g;
#pragma unroll
            for (int eb = 0; eb < 8; ++eb) mor[eb] = *(const v2u*)(mo + 16 * eb); }
#pragma unroll 2
        for (int i = 0; i < 4; ++i) {
            f32x4 sc2[2];
#pragma unroll
            for (int h2 = 0; h2 < 2; ++h2) { bf16x8 ka[4];
#pragma unroll
                for (int s = 0; s < 4; ++s) ka[s] = *(const LAS bf16x8*)(lds + (2 * i + h2) * 4096 + rb[s]);
                sc2[h2] = (f32x4){0.f, 0.f, 0.f, 0.f};
#pragma unroll
                for (int s = 0; s < 4; ++s) sc2[h2] = mfma16(ka[s], qf[s], sc2[h2]); }
            float pe[2][4];
#pragma unroll
            for (int h2 = 0; h2 < 2; ++h2)
#pragma unroll
                for (int q = 0; q < 4; ++q) { const float v = (16 * (2 * i + h2) + 4 * g + q <= lq) ? sc2[h2][q] : 0.f; pe[h2][q] = v; dsum += v; }
            v4u pw; pw.x = pk2(pe[0][0], pe[0][1]); pw.y = pk2(pe[0][2], pe[0][3]); pw.z = pk2(pe[1][0], pe[1][1]); pw.w = pk2(pe[1][2], pe[1][3]);
            const bf16x8 pf = __builtin_bit_cast(bf16x8, pw);
#pragma unroll
            for (int hf = 0; hf < 2; ++hf) {
                s16x4 va[4][2];
#pragma unroll
                for (int e4 = 0; e4 < 4; ++e4) { va[e4][0] = tr_read(lds + vb[4 * hf + e4] + i * 8192); va[e4][1] = tr_read(lds + vb[4 * hf + e4] + i * 8192 + 4096); }
#pragma unroll
                for (int e4 = 0; e4 < 4; ++e4) acc[4 * hf + e4] = mfma16(cat44(va[e4][0], va[e4][1]), pf, acc[4 * hf + e4]);
            }
        }
        dsum += __shfl_xor(dsum, 16); dsum += __shfl_xor(dsum, 32);
        const float den = cs * qn + dsum, inv = 1.0f / fmaxf(fabsf(den), fl);
        float ss = 0.f;
#pragma unroll
        for (int eb = 0; eb < 8; ++eb) { acc[eb] = acc[eb] * inv; ss += (acc[eb][0] * acc[eb][0] + acc[eb][1] * acc[eb][1]) + (acc[eb][2] * acc[eb][2] + acc[eb][3] * acc[eb][3]); }
        ss += __shfl_xor(ss, 16); ss += __shfl_xor(ss, 32);
        const float rstd = __builtin_amdgcn_rsqf(ss * (1.f / HD) + EPS);
        bf16* op = mix + (t0 + lq) * DM + AW + h * 128 + 4 * g;
        const LAS float* ngp = sm + 640 + 4 * g;
#pragma unroll
        for (int eb = 0; eb < 8; ++eb) {
            const v2u mr = mor[eb]; const f32x4 gv = *(const LAS f32x4*)(ngp + 16 * eb);
            const float o0 = acc[eb][0] * rstd * gv.x * sigmf(bf_lo(mr.x)), o1 = acc[eb][1] * rstd * gv.y * sigmf(bf_hi(mr.x)), o2 = acc[eb][2] * rstd * gv.z * sigmf(bf_lo(mr.y)), o3 = acc[eb][3] * rstd * gv.w * sigmf(bf_hi(mr.y));
            v2u o; o.x = pk2(o0, o1); o.y = pk2(o2, o3); if (MODE == 0) *(v2u*)(op + 16 * eb) = o; else asm volatile("" :: "v"(o.x), "v"(o.y));
        }
        LBAR();
        if (!more) break;
        idx = idn;
    }
}

struct Args { const float* in[14]; float* out; unsigned char* ws; int ph_lo, ph_hi, li, pad; };
__global__ void __launch_bounds__(NWAVES * 64, 2) hyb_fwd(Args args) {
    extern __shared__ __attribute__((aligned(16))) unsigned char lds_raw[];
    LAS unsigned char* lds = (LAS unsigned char*)lds_raw;
    volatile LAS unsigned* MISC = (volatile LAS unsigned*)(lds + MISC_OFF);
    LAS float* sm = (LAS float*)(lds + SM_OFF);
    const int tid = threadIdx.x, lane = tid & 63, wave = __builtin_amdgcn_readfirstlane(tid >> 6);
    const int G = gridDim.x; const int bx = blockIdx.x; const int vcu = (G % 8 == 0) ? (bx % 8) * (G / 8) + bx / 8 : bx;
    unsigned char* ws = args.ws;
    gu32* ctl = (gu32*)(ws + WS_CTL);
    for (int u = tid; u < (LDS_BYTES - LDSCTL_OFF) / 4; u += NWAVES * 64) ((LAS unsigned*)(lds + LDSCTL_OFF))[u] = 0u;
    __syncthreads();
    const XcdBarrier bar = xcd_barrier_post((unsigned*)(ctl + CW_BAR) + args.li * XCD_BAR_WORDS, MISC + 8);
#define GRID_BAR() xcd_barrier(bar)
#ifdef PROBE_T
#define STAMP(k) do { if (bx == 0 && tid == 0) MISC[16 + (k)] = (unsigned)wall_clock64(); } while (0)
#else
#define STAMP(k) do { } while (0)
#endif
    STAMP(0);
    const int lo = args.ph_lo, hi = args.ph_hi;
#ifndef PH_MASK
#define PH_MASK 0xffffff
#endif
#define IN(k) (((PH_MASK >> (k)) & 1) && lo <= (k) && (k) < hi)
#define BOTH(k) (IN(k) && IN((k) + 1))

    bf16* WIN = (bf16*)(ws + WS_WIN); bf16* WOUT = (bf16*)(ws + WS_WOUT); bf16* WGU = (bf16*)(ws + WS_WGU); bf16* WDN = (bf16*)(ws + WS_WDN);
    bf16* HB = (bf16*)(ws + WS_HB); bf16* KVT = (bf16*)(ws + WS_HB); bf16* PROJ = (bf16*)(ws + WS_PROJ); bf16* HID = (bf16*)(ws + WS_PROJ); bf16* MIX = (bf16*)(ws + WS_MIX);
    float* GATES = (float*)(ws + WS_GATES); float* LSE = (float*)(ws + WS_LSE); float* NCHK = (float*)(ws + WS_NCH); float* NPREV = (float*)(ws + WS_NPREV); float* SC = (float*)(ws + WS_SC);
    float* ROWSS = (float*)(ws + WS_CTL) + CW_ROWSS; bf16* KC = (bf16*)(ws + WS_KC); float* GS = (float*)(ws + WS_GS);
    bf16* OG = (bf16*)((unsigned char*)args.out + DO_ATT); bf16* CPT = (bf16*)((unsigned char*)args.out + DO_CPT);

    if (IN(0)) { p0_prologue<3>(lds, sm, args.in, ws, vcu, G, tid, lane, wave); if (BOTH(0)) GRID_BAR(); STAMP(1); }
#ifdef PROBE_P0
    if (IN(8)) p0_prologue<1>(lds, sm, args.in, ws, vcu, G, tid, lane, wave);
    if (IN(9)) p0_prologue<2>(lds, sm, args.in, ws, vcu, G, tid, lane, wave);
#endif

    if (IN(1)) {
        pg8::Gemm g{HB, WIN, T, PJ, DM}; pg8::StaticOrder S; S.init(T, PJ, G, bx);
        pg8::EpiProj E{PROJ, T, args.in[6], args.in[7], sm, EPS, RSQRT_HD * LOG2E};
        pg8::gemm_phase<pg8::EpiProj, pg8::StaticOrder, true, true>(lds, g, S, E);
        if (BOTH(1)) GRID_BAR(); STAMP(2);
    }

    if (IN(2)) {
        attn_phase<0>(lds, PROJ, OG, LSE, args.in[6], args.in[7], vcu, G, tid, lane, wave); STAMP(9);
        mlstmA_phase(lds, sm, PROJ, GATES, args.in[3], args.in[4], KVT, NCHK, SC, GS, KC, MIX, vcu, G, tid, lane, wave);
        if (BOTH(2)) GRID_BAR(); STAMP(3);
    }

#ifdef PROBE_P2
    if (IN(10)) attn_phase<0>(lds, PROJ, OG, LSE, args.in[6], args.in[7], vcu, G, tid, lane, wave);
    if (IN(12)) attn_phase<1>(lds, PROJ, OG, LSE, args.in[6], args.in[7], vcu, G, tid, lane, wave);
    if (IN(13)) attn_phase<2>(lds, PROJ, OG, LSE, args.in[6], args.in[7], vcu, G, tid, lane, wave);
    if (IN(11)) mlstmA_phase(lds, sm, PROJ, GATES, args.in[3], args.in[4], KVT, NCHK, SC, GS, KC, MIX, vcu, G, tid, lane, wave);
#endif
    if (IN(3)) { p3_scan_merge(KVT, NCHK, SC, CPT, NPREV, OG, LSE, MIX, vcu, G, tid); if (BOTH(3)) GRID_BAR(); STAMP(4); }

    if (IN(4)) {
        mlstmC_phase<0>(lds, sm, PROJ, GS, KC, CPT, NPREV, SC, args.in[8], MIX, vcu, G, tid, lane, wave);
        if (BOTH(4)) GRID_BAR(); STAMP(5);
    }

#ifdef PROBE_P4
    if (IN(15)) mlstmC_phase<1>(lds, sm, PROJ, GS, KC, CPT, NPREV, SC, args.in[8], MIX, vcu, G, tid, lane, wave);
    if (IN(16)) mlstmC_phase<2>(lds, sm, PROJ, GS, KC, CPT, NPREV, SC, args.in[8], MIX, vcu, G, tid, lane, wave);
#endif
    if (IN(5)) {
        pg8::Gemm g{MIX, WOUT, T, DM, DM}; pg8::StaticOrder S; S.init(T, DM, G, bx);
        pg8::EpiRes1 E{args.in[0], args.out, HB, ROWSS, DM};
        pg8::gemm_phase<pg8::EpiRes1, pg8::StaticOrder, false, true>(lds, g, S, E);
        if (BOTH(5)) GRID_BAR(); STAMP(6);
    }

#ifdef PROBE_SLEEP
    { const long long until = wall_clock64() + 10000; while (wall_clock64() < until) __builtin_amdgcn_s_sleep(32); }
#endif
    if (IN(6)) {
        pg8::Gemm g{HB, WGU, T, 2 * FF, DM}; pg8::StaticOrder S; S.init(T, 2 * FF, G, bx);
        pg8::EpiSwi E{HID, FF, ROWSS, EPS};
        pg8::gemm_phase<pg8::EpiSwi, pg8::StaticOrder, false, true>(lds, g, S, E);
        if (BOTH(6)) GRID_BAR(); STAMP(7);
    }

#ifdef PROBE_G
    if (IN(17)) { pg8::Gemm g{PROJ, PROJ + (size_t)T * DM, T, 2 * FF, DM}; pg8::StaticOrder S; S.init(T, 2 * FF, G, bx); pg8::EpiNone E{}; pg8::gemm_phase<pg8::EpiNone, pg8::StaticOrder, true, true>(lds, g, S, E); }
    if (IN(14)) { pg8::Gemm g{HB, WGU, T, 2 * FF, DM}; pg8::StaticOrder S; S.init(T, 2 * FF, G, bx); pg8::EpiNone E{}; pg8::gemm_phase<pg8::EpiNone, pg8::StaticOrder, true, true>(lds, g, S, E); }
#endif
    if (IN(7)) {
        pg8::Gemm g{HID, WDN, T, DM, FF}; pg8::StaticOrder S; S.init(T, DM, G, bx);
        pg8::EpiRes2 E{args.out, DM};
        pg8::gemm_phase<pg8::EpiRes2, pg8::StaticOrder, false, true>(lds, g, S, E);
    }
    STAMP(8);
#ifdef PROBE_T
    if (bx == 0 && tid == 0) {
#ifdef PROBE_TA
        const unsigned dt = MISC[16 + PROBE_TB] - MISC[16 + PROBE_TA];
#else
        const unsigned dt = MISC[16 + PROBE_T + 1] - MISC[16 + PROBE_T];
#endif
        const long long until = wall_clock64() + (long long)dt * 10;
        while (wall_clock64() < until) __builtin_amdgcn_s_sleep(8); }
#endif
#undef IN
#undef BOTH
}

extern "C" void kernel_launch(void* const* d_in, const int* in_sizes, int n_in, void* d_out, int out_size, void* d_ws, size_t ws_size, hipStream_t stream) {
    static int grid = 0;
    if (grid == 0) {
        if (n_in != 14 || in_sizes[0] != T * DM || out_size != T * DM || ws_size < WS_END) { fprintf(stderr, "kernel_launch: unexpected shapes (n_in %d, in0 %d, out %d, ws %zu); nothing launched\n", n_in, n_in > 0 ? in_sizes[0] : -1, out_size, ws_size); grid = -1; return; }
        int dev = 0, cus = 0, per_cu = 0;
        if (hipGetDevice(&dev) != hipSuccess || hipDeviceGetAttribute(&cus, hipDeviceAttributeMultiprocessorCount, dev) != hipSuccess) { fprintf(stderr, "kernel_launch: hipGetDevice / hipDeviceGetAttribute failed\n"); grid = -1; return; }
        if (hipFuncSetAttribute((const void*)hyb_fwd, hipFuncAttributeMaxDynamicSharedMemorySize, LDS_BYTES) != hipSuccess) { fprintf(stderr, "kernel_launch: hipFuncSetAttribute failed\n"); grid = -1; return; }
        if (hipOccupancyMaxActiveBlocksPerMultiprocessor(&per_cu, (const void*)hyb_fwd, NWAVES * 64, LDS_BYTES) != hipSuccess || per_cu < 1)
            fprintf(stderr, "kernel_launch: note: occupancy query reports %d workgroups per CU\n", per_cu);
        (void)hipGetLastError();
        grid = cus;
    }
    if (grid < 0) return;
    if (hipMemsetAsync((char*)d_ws + WS_CTL, 0, CTL_ZERO_BYTES, stream) != hipSuccess) { fprintf(stderr, "kernel_launch: hipMemsetAsync failed\n"); return; }
    Args a{};
    for (int i = 0; i < 14; ++i) a.in[i] = (const float*)d_in[i];
    a.out = (float*)d_out; a.ws = (unsigned char*)d_ws;
    static const int plist[] = PHASE_LIST;
    constexpr int NL = (int)(sizeof(plist) / sizeof(int)) / 2;
    static_assert(NL >= 1 && NL <= 16, "launch list");
    for (int li = 0; li < NL; ++li) {
        a.ph_lo = plist[2 * li]; a.ph_hi = plist[2 * li + 1]; a.li = li;
        hipLaunchKernelGGL(hyb_fwd, dim3(grid), dim3(NWAVES * 64), LDS_BYTES, stream, a);
        const hipError_t le = hipPeekAtLastError();
        if (le != hipSuccess) { fprintf(stderr, "kernel_launch: launch %d failed: %s\n", li, hipGetErrorName(le)); break; }
    }
}
```

```cpp
#include <hip/hip_runtime.h>
#include <cstdio>
#include <cstdint>
namespace pg8 {
#define PG8_LAS __attribute__((address_space(3)))
typedef unsigned short bf16_t;
typedef short bf16x8 __attribute__((ext_vector_type(8)));
typedef float f32x4 __attribute__((ext_vector_type(4)));
typedef unsigned u32x4 __attribute__((ext_vector_type(4)));
constexpr int BM = 256, BK = 64, HALF = 128, HTB = HALF * BK * 2  , STAGE_BYTES = 8 * HTB, NXCD = 8, WGM = 8;

__host__ __device__ __forceinline__ int lds_byte(int r, int c) { const int st = (r >> 4) * 2 + (c >> 5), rr = r & 15, cc = c & 31, ob = rr * 64 + cc * 2; return st * 1024 + (ob ^ (((ob >> 9) & 1) << 5)); }
__host__ __device__ __forceinline__ void stage_rc(int b, int& R, int& C) { const int st = b / 1024, sb = b % 1024, swz = sb ^ (((sb >> 9) & 1) << 5); R = (st >> 1) * 16 + swz / 64; C = (st & 1) * 32 + (swz % 64) / 2; }
__host__ __device__ __forceinline__ int perm32(int rho) { const int n = rho >> 4, i = rho & 15; return 8 * (i >> 2) + 4 * n + (i & 3); }

struct Unit { int pm, pn; };
struct Gemm { const bf16_t* A; const bf16_t* Bt; int M, N, K; };

struct StaticOrder {
    int nM, nN, nwg, G, c;
    __host__ __device__ void init(int M, int N, int G_, int c_) { nM = M / BM; nN = N / BM; nwg = nM * nN; G = G_; c = c_; }
    __host__ __device__ bool next(int i, Unit& u) const {
        const long L = (long)i * G + c; if (L >= nwg) return false;
        int wgid = (int)L; { const int q = nwg / NXCD, r = nwg % NXCD, xcd = wgid % NXCD, off = wgid / NXCD; wgid = (xcd < r ? xcd * (q + 1) : r * (q + 1) + (xcd - r) * q) + off; }
        const int nig = WGM * nN, gid = wgid / nig, fm = gid * WGM, gsz = (nM - fm) < WGM ? (nM - fm) : WGM;
        u.pm = fm + ((wgid % nig) % gsz); u.pn = (wgid % nig) / gsz; return true;
    }
    __device__ __forceinline__ void a_ready(const Unit&) const {}
    __device__ __forceinline__ void done(const Unit&) const {}
};
typedef float f32x2 __attribute__((ext_vector_type(2)));
typedef __bf16 bf16x2_t __attribute__((ext_vector_type(2)));
typedef unsigned u32x2 __attribute__((ext_vector_type(2)));
__device__ __forceinline__ unsigned cvt_pk_bf16(float lo, float hi) { f32x2 v = {lo, hi}; bf16x2_t b = __builtin_convertvector(v, bf16x2_t); return __builtin_bit_cast(unsigned, b); }

struct EpiProj {
    static constexpr bool PERM = true, AFTER_DRAIN = false;
    bf16_t* O; int ldc  ; const float* qg; const float* kg; PG8_LAS float* sm; float eps, qscale;
    __device__ __forceinline__ void operator()(const f32x4 (&acc)[2][2][4][2], const Unit& u, int wr, int wc, int fr, int fq) const {
        const int row0 = u.pm * BM + wr * 64 + fr, col0 = wc * 32 + 8 * fq;
        bf16_t* const slab = O + (size_t)(2 * u.pn) * ldc * HALF;
        if (u.pn < 8) {
            const float* gsrc = (u.pn < 4 ? qg : kg) + wc * 32 + 8 * fq; const float extra = u.pn < 4 ? qscale : 1.0f;
            const f32x4 ga = *(const f32x4*)gsrc, gb = *(const f32x4*)(gsrc + 4);
#pragma unroll
            for (int ai = 0; ai < 2; ++ai)
#pragma unroll
                for (int m = 0; m < 4; ++m)
#pragma unroll
                    for (int bj = 0; bj < 2; ++bj) { const f32x4 v0 = acc[ai][bj][m][0], v1 = acc[ai][bj][m][1];
                        float s = ((v0[0] * v0[0] + v0[1] * v0[1]) + (v0[2] * v0[2] + v0[3] * v0[3])) + ((v1[0] * v1[0] + v1[1] * v1[1]) + (v1[2] * v1[2] + v1[3] * v1[3]));
                        s += __shfl_xor(s, 16); s += __shfl_xor(s, 32);
                        if (fq == 0) sm[((ai * HALF + wr * 64 + m * 16 + fr) * 2 + bj) * 4 + wc] = s; }
            asm volatile("s_waitcnt lgkmcnt(0)" ::: "memory"); __builtin_amdgcn_s_barrier(); asm volatile("" ::: "memory");
#pragma unroll
            for (int ai = 0; ai < 2; ++ai)
#pragma unroll
                for (int m = 0; m < 4; ++m) { bf16_t* rowp = slab + (size_t)(row0 + ai * HALF + m * 16) * HALF + col0;
#pragma unroll
                    for (int bj = 0; bj < 2; ++bj) { const f32x4 pv = *(const PG8_LAS f32x4*)(sm + ((ai * HALF + wr * 64 + m * 16 + fr) * 2 + bj) * 4);
                        const float rs = __builtin_amdgcn_rsqf(((pv[0] + pv[1]) + (pv[2] + pv[3])) * (1.0f / 128.0f) + eps) * extra;
                        const f32x4 v0 = acc[ai][bj][m][0] * ga * rs, v1 = acc[ai][bj][m][1] * gb * rs;
                        u32x4 w; w.x = cvt_pk_bf16(v0[0], v0[1]); w.y = cvt_pk_bf16(v0[2], v0[3]); w.z = cvt_pk_bf16(v1[0], v1[1]); w.w = cvt_pk_bf16(v1[2], v1[3]);
                        *(u32x4*)(rowp + (size_t)bj * ldc * HALF) = w; } }
            asm volatile("s_waitcnt lgkmcnt(0)" ::: "memory"); __builtin_amdgcn_s_barrier(); asm volatile("" ::: "memory");
            return;
        }
#pragma unroll
        for (int ai = 0; ai < 2; ++ai)
#pragma unroll
            for (int m = 0; m < 4; ++m) { bf16_t* rowp = slab + (size_t)(row0 + ai * HALF + m * 16) * HALF + col0;
#pragma unroll
                for (int bj = 0; bj < 2; ++bj) { const f32x4 v0 = acc[ai][bj][m][0], v1 = acc[ai][bj][m][1];
                    u32x4 w; w.x = cvt_pk_bf16(v0[0], v0[1]); w.y = cvt_pk_bf16(v0[2], v0[3]); w.z = cvt_pk_bf16(v1[0], v1[1]); w.w = cvt_pk_bf16(v1[2], v1[3]);
                    *(u32x4*)(rowp + (size_t)bj * ldc * HALF) = w; } }
    }
};
struct EpiRes1 {
    static constexpr bool PERM = true, AFTER_DRAIN = false, INIT = false;
    const float* X; float* X1; bf16_t* X1B; float* rowss; int ldc;
    __device__ __forceinline__ void operator()(const f32x4 (&acc)[2][2][4][2], const Unit& u, int wr, int wc, int fr, int fq) const {
        const int row0 = u.pm * BM + wr * 64 + fr, col0 = u.pn * BM + wc * 32 + 8 * fq;
#pragma unroll
        for (int ai = 0; ai < 2; ++ai)
#pragma unroll
            for (int m = 0; m < 4; ++m) { const int r = row0 + ai * HALF + m * 16; const size_t off = (size_t)r * ldc + col0; float ss = 0.f;
#pragma unroll
                for (int bj = 0; bj < 2; ++bj) { const size_t c = off + bj * HALF;
                    const f32x4 v0 = __builtin_nontemporal_load((const f32x4*)(X + c)) + acc[ai][bj][m][0], v1 = __builtin_nontemporal_load((const f32x4*)(X + c + 4)) + acc[ai][bj][m][1];
                    *(f32x4*)(X1 + c) = v0; *(f32x4*)(X1 + c + 4) = v1;
                    ss += ((v0[0] * v0[0] + v0[1] * v0[1]) + (v0[2] * v0[2] + v0[3] * v0[3])) + ((v1[0] * v1[0] + v1[1] * v1[1]) + (v1[2] * v1[2] + v1[3] * v1[3]));
                    u32x4 w; w.x = cvt_pk_bf16(v0[0], v0[1]); w.y = cvt_pk_bf16(v0[2], v0[3]); w.z = cvt_pk_bf16(v1[0], v1[1]); w.w = cvt_pk_bf16(v1[2], v1[3]); *(u32x4*)(X1B + c) = w; }
                ss += __shfl_xor(ss, 16); ss += __shfl_xor(ss, 32);
                if (fq == 0) atomicAdd(rowss + r, ss);
                if (m == 3) asm volatile("" ::: "memory"); }
    }
};
struct EpiSwi {
    static constexpr bool PERM = true, AFTER_DRAIN = false;
    bf16_t* H; int ldc; const float* rowss; float eps;
    __device__ __forceinline__ void operator()(const f32x4 (&acc)[2][2][4][2], const Unit& u, int wr, int wc, int fr, int fq) const {
        const int row0 = u.pm * BM + wr * 64 + fr, col0 = u.pn * HALF + wc * 32 + 8 * fq;
        float rsv[2][4];
#pragma unroll
        for (int ai = 0; ai < 2; ++ai)
#pragma unroll
            for (int m = 0; m < 4; ++m) rsv[ai][m] = rowss[row0 + ai * HALF + m * 16];
#pragma unroll
        for (int ai = 0; ai < 2; ++ai)
#pragma unroll
            for (int m = 0; m < 4; ++m) { const int r = row0 + ai * HALF + m * 16; const float s = __builtin_amdgcn_rsqf(rsv[ai][m] * (1.0f / 2048.0f) + eps);
                float hv[8];
#pragma unroll
                for (int n = 0; n < 2; ++n)
#pragma unroll
                    for (int j = 0; j < 4; ++j) { const float g = acc[ai][0][m][n][j] * s, up = acc[ai][1][m][n][j] * s; hv[n * 4 + j] = g * __builtin_amdgcn_rcpf(1.0f + __expf(-g)) * up; }
                u32x4 w; w.x = cvt_pk_bf16(hv[0], hv[1]); w.y = cvt_pk_bf16(hv[2], hv[3]); w.z = cvt_pk_bf16(hv[4], hv[5]); w.w = cvt_pk_bf16(hv[6], hv[7]);
                *(u32x4*)(H + (size_t)r * ldc + col0) = w; }
    }
};
struct EpiNone {
    static constexpr bool PERM = true, AFTER_DRAIN = false;
    __device__ __forceinline__ void operator()(const f32x4 (&acc)[2][2][4][2], const Unit& u, int wr, int wc, int fr, int fq) const {
#pragma unroll
        for (int ai = 0; ai < 2; ++ai)
#pragma unroll
            for (int m = 0; m < 4; ++m)
#pragma unroll
                for (int bj = 0; bj < 2; ++bj) asm volatile("" :: "v"(acc[ai][bj][m][0]), "v"(acc[ai][bj][m][1]));
    }
};
struct EpiRes2 {
    static constexpr bool PERM = true, AFTER_DRAIN = false, INIT = false;
    float* OUT; int ldc;
    __device__ __forceinline__ void operator()(const f32x4 (&acc)[2][2][4][2], const Unit& u, int wr, int wc, int fr, int fq) const {
        const int row0 = u.pm * BM + wr * 64 + fr, col0 = u.pn * BM + wc * 32 + 8 * fq;
#pragma unroll
        for (int ai = 0; ai < 2; ++ai)
#pragma unroll
            for (int m = 0; m < 4; ++m) { float* rowp = OUT + (size_t)(row0 + ai * HALF + m * 16) * ldc + col0;
#pragma unroll
                for (int bj = 0; bj < 2; ++bj) { f32x4* p = (f32x4*)(rowp + bj * HALF); const f32x4 a = p[0] + acc[ai][bj][m][0], b = p[1] + acc[ai][bj][m][1]; p[0] = a; p[1] = b; }
                if (m == 3) asm volatile("" ::: "memory"); }
    }
};

template <class Epi, class Sched, bool ALIGN_EPI = false, bool SP2 = false>
__device__ __forceinline__ void gemm_phase(PG8_LAS unsigned char* lds, const Gemm g, const Sched& S, const Epi& E) {
    const int tid = threadIdx.x, wid = __builtin_amdgcn_readfirstlane(tid >> 6), lane = tid & 63, wr = wid >> 2, wc = wid & 3, fr = lane & 15, fq = lane >> 4;
    const int K = g.K, nt = K / BK;
    unsigned voffA[2], voffB[2];
#pragma unroll
    for (int i = 0; i < 2; ++i) { int R, C; stage_rc(tid * 16 + i * 8192, R, C); const int Rb = Epi::PERM ? ((R & ~31) + perm32(R & 31)) : R;
        voffA[i] = (unsigned)(R * K + C) * 2u; voffB[i] = (unsigned)(Rb * K + C) * 2u; }
    const size_t kstep = (size_t)(BK * 2);
    const size_t hstep = (size_t)HALF * K * 2;
    const size_t tstep = 2 * hstep;
    const unsigned ldsw = (unsigned)wid * 1024u;
    const int aoff = lds_byte(wr * 64 + fr, fq * 8), boff = lds_byte(wc * 32 + fr, fq * 8);
#define PG8_SA(b, h) (((b) * 2 + (h)) * HTB)
#define PG8_SB(b, h) ((4 + (b) * 2 + (h)) * HTB)
#define PG8_STAGE(bufoff, gbase, voff) do { _Pragma("unroll") for (int _i = 0; _i < 2; ++_i) \
        __builtin_amdgcn_global_load_lds((const unsigned*)((const char*)(gbase) + (voff)[_i]), (PG8_LAS unsigned*)(lds + (bufoff) + ldsw + _i * 8192), 16, 0, 0); } while (0)
#define PG8_LDA(dst, b, h) do { _Pragma("unroll") for (int m = 0; m < 4; ++m) _Pragma("unroll") for (int k = 0; k < 2; ++k) dst[m][k] = *(const PG8_LAS bf16x8*)(lds + PG8_SA(b, h) + aoff + m * 2048 + k * 1024); } while (0)
#define PG8_LDB(dst, b, h) do { _Pragma("unroll") for (int n = 0; n < 2; ++n) _Pragma("unroll") for (int k = 0; k < 2; ++k) dst[n][k] = *(const PG8_LAS bf16x8*)(lds + PG8_SB(b, h) + boff + n * 2048 + k * 1024); } while (0)
#define PG8_MMA(ai, bj, At, Bt) do { __builtin_amdgcn_s_setprio(1); _Pragma("unroll") for (int m = 0; m < 4; ++m) _Pragma("unroll") for (int n = 0; n < 2; ++n) _Pragma("unroll") for (int k = 0; k < 2; ++k) \
        acc[ai][bj][m][n] = __builtin_amdgcn_mfma_f32_16x16x32_bf16(Bt[n][k], At[m][k], acc[ai][bj][m][n], 0, 0, 0); __builtin_amdgcn_s_setprio(0); } while (0)
#define PG8_WAIT_V(n) asm volatile("s_waitcnt vmcnt(" #n ")" ::: "memory")
#define PG8_WAIT_L(n) asm volatile("s_waitcnt lgkmcnt(" #n ")" ::: "memory")
#define PG8_BAR __builtin_amdgcn_s_barrier()
#define PG8_SCHED __builtin_amdgcn_sched_barrier(0)
    Unit cur, nxt; int ui = 0;
    if (!S.next(0, cur)) return;
    f32x4 acc[2][2][4][2];
#pragma unroll
    for (int a = 0; a < 2; ++a)
#pragma unroll
        for (int b = 0; b < 2; ++b)
#pragma unroll
            for (int m = 0; m < 4; ++m)
#pragma unroll
                for (int n = 0; n < 2; ++n) acc[a][b][m][n] = (f32x4){0.f, 0.f, 0.f, 0.f};
    bf16x8 At[4][2], B0[2][2], B1[2][2];
    const char* cA = (const char*)g.A + (size_t)cur.pm * tstep; const char* cB = (const char*)g.Bt + (size_t)cur.pn * tstep;
    S.a_ready(cur);
    if constexpr (SP2) {
        PG8_STAGE(PG8_SB(0, 0), cB, voffB); PG8_STAGE(PG8_SB(0, 1), cB + hstep, voffB); PG8_STAGE(PG8_SA(0, 0), cA, voffA); PG8_STAGE(PG8_SA(0, 1), cA + hstep, voffA);
        if (wr == 1) PG8_BAR;
        PG8_WAIT_V(2); PG8_BAR;
        PG8_STAGE(PG8_SB(1, 0), cB + kstep, voffB); PG8_STAGE(PG8_SA(1, 0), cA + kstep, voffA); PG8_STAGE(PG8_SB(1, 1), cB + hstep + kstep, voffB);
        PG8_WAIT_V(6); PG8_BAR;
    } else {
        PG8_STAGE(PG8_SB(0, 0), cB, voffB); PG8_STAGE(PG8_SA(0, 0), cA, voffA); PG8_STAGE(PG8_SB(0, 1), cB + hstep, voffB); PG8_STAGE(PG8_SA(0, 1), cA + hstep, voffA);
        if (wr == 1) PG8_BAR;
        PG8_WAIT_V(4); PG8_BAR;
        PG8_STAGE(PG8_SB(1, 0), cB + kstep, voffB); PG8_STAGE(PG8_SA(1, 0), cA + kstep, voffA); PG8_STAGE(PG8_SB(1, 1), cB + hstep + kstep, voffB);
        PG8_WAIT_V(6); PG8_BAR;
    }
    for (;;) {
        const bool has_next = S.next(ui + 1, nxt);
        const char* nA = has_next ? (const char*)g.A + (size_t)nxt.pm * tstep : cA; const char* nB = has_next ? (const char*)g.Bt + (size_t)nxt.pn * tstep : cB;
        for (int t = 0; t < nt; t += 2) {
            const bool last = (t == nt - 2);
            const char* a1 = cA + (size_t)(t + 1) * kstep;
            const char* a2 = last ? nA : cA + (size_t)(t + 2) * kstep; const char* b2 = last ? nB : cB + (size_t)(t + 2) * kstep;
            const char* a3 = a2 + kstep; const char* b3 = b2 + kstep;
            if (last && has_next) S.a_ready(nxt);
            if constexpr (SP2) {
            PG8_LDB(B0, 0, 0); PG8_LDB(B1, 0, 1); PG8_SCHED; PG8_LDA(At, 0, 0); PG8_STAGE(PG8_SA(1, 1), a1 + hstep, voffA);
            PG8_WAIT_V(8); PG8_WAIT_L(0); PG8_BAR; PG8_MMA(0, 0, At, B0); PG8_MMA(0, 1, At, B1); PG8_BAR; PG8_SCHED;
            PG8_LDA(At, 0, 1); PG8_STAGE(PG8_SB(0, 0), b2, voffB); PG8_STAGE(PG8_SB(0, 1), b2 + hstep, voffB); PG8_STAGE(PG8_SA(0, 0), a2, voffA);
            PG8_WAIT_V(8); PG8_WAIT_L(0); PG8_BAR; PG8_MMA(1, 0, At, B0); PG8_MMA(1, 1, At, B1); PG8_BAR; PG8_SCHED;
            PG8_LDB(B0, 1, 0); PG8_LDB(B1, 1, 1); PG8_SCHED; PG8_LDA(At, 1, 0); PG8_STAGE(PG8_SA(0, 1), a2 + hstep, voffA);
            PG8_WAIT_V(8); PG8_WAIT_L(0); PG8_BAR; PG8_MMA(0, 0, At, B0); PG8_MMA(0, 1, At, B1); PG8_BAR; PG8_SCHED;
            PG8_LDA(At, 1, 1); PG8_STAGE(PG8_SB(1, 0), b3, voffB); PG8_STAGE(PG8_SB(1, 1), b3 + hstep, voffB); PG8_STAGE(PG8_SA(1, 0), a3, voffA);
            PG8_WAIT_V(8); PG8_WAIT_L(0); PG8_BAR; PG8_MMA(1, 0, At, B0); PG8_MMA(1, 1, At, B1); PG8_BAR; PG8_SCHED;
            } else {
            PG8_LDB(B0, 0, 0); PG8_SCHED; PG8_LDA(At, 0, 0); PG8_STAGE(PG8_SA(1, 1), a1 + hstep, voffA);
            PG8_WAIT_L(8); PG8_BAR; PG8_WAIT_L(0); PG8_MMA(0, 0, At, B0); PG8_BAR; PG8_SCHED;
            PG8_LDB(B1, 0, 1); PG8_STAGE(PG8_SB(0, 0), b2, voffB);
            PG8_BAR; PG8_WAIT_L(0); PG8_MMA(0, 1, At, B1); PG8_BAR;
            PG8_LDA(At, 0, 1); PG8_STAGE(PG8_SA(0, 0), a2, voffA);
            PG8_BAR; PG8_WAIT_L(0); PG8_MMA(1, 0, At, B0); PG8_BAR; PG8_SCHED;
            PG8_STAGE(PG8_SB(0, 1), b2 + hstep, voffB);
            PG8_WAIT_V(6); PG8_BAR; PG8_MMA(1, 1, At, B1); PG8_BAR;
            PG8_LDB(B0, 1, 0); PG8_SCHED; PG8_LDA(At, 1, 0); PG8_STAGE(PG8_SA(0, 1), a2 + hstep, voffA);
            PG8_WAIT_L(8); PG8_BAR; PG8_WAIT_L(0); PG8_MMA(0, 0, At, B0); PG8_BAR; PG8_SCHED;
            PG8_LDB(B1, 1, 1); PG8_STAGE(PG8_SB(1, 0), b3, voffB);
            PG8_BAR; PG8_WAIT_L(0); PG8_MMA(0, 1, At, B1); PG8_BAR;
            PG8_LDA(At, 1, 1); PG8_STAGE(PG8_SA(1, 0), a3, voffA);
            PG8_BAR; PG8_WAIT_L(0); PG8_MMA(1, 0, At, B0); PG8_BAR; PG8_SCHED;
            PG8_STAGE(PG8_SB(1, 1), b3 + hstep, voffB);
            PG8_WAIT_V(6); PG8_BAR; PG8_MMA(1, 1, At, B1); PG8_BAR;
            }
        }
        if constexpr (ALIGN_EPI) { if (wr == 0) PG8_BAR; }
        if constexpr (!Epi::AFTER_DRAIN) { E(acc, cur, wr, wc, fr, fq); S.done(cur); }
        if (!has_next) break;
#pragma unroll
        for (int a = 0; a < 2; ++a)
#pragma unroll
            for (int b = 0; b < 2; ++b)
#pragma unroll
                for (int m = 0; m < 4; ++m)
#pragma unroll
                    for (int n = 0; n < 2; ++n) acc[a][b][m][n] = (f32x4){0.f, 0.f, 0.f, 0.f};
        cur = nxt; cA = nA; cB = nB; ++ui;
        if constexpr (ALIGN_EPI) { if (wr == 1) PG8_BAR; }
    }
    PG8_WAIT_V(0);
    if constexpr (!ALIGN_EPI) { if (wr == 0) PG8_BAR; }
    PG8_BAR;
    if constexpr (Epi::AFTER_DRAIN) { E.fused(acc, cur, wr, wc, fr, fq, lds, wid, lane); S.done(cur); }
#undef PG8_SA
#undef PG8_SB
#undef PG8_STAGE
#undef PG8_LDA
#undef PG8_LDB
#undef PG8_MMA
#undef PG8_WAIT_V
#undef PG8_WAIT_L
#undef PG8_BAR
#undef PG8_SCHED
}
}

constexpr int NWAVES = 8;
#ifndef PHASE_LIST
#define PHASE_LIST {0, 8}
#endif
constexpr int N_PHASES = 8;

constexpr int BATCH = 4, SEQ = 4096, DM = 2048, HD = 128, NH = 8, AW = 1024, FF = 5632;
constexpr int T = BATCH * SEQ;
constexpr int INW = 7184, PJ = 7168;
constexpr int S_AQ = 0, S_AK = 1, S_AV = 2, S_MQ = 3, S_MK = 4, S_MV = 5, S_MO = 6;
constexpr int NCH = SEQ / 128;
constexpr float EPS = 1e-6f;
constexpr float LOG2E = 1.4426950408889634f, LN2 = 0.6931471805599453f;
constexpr float RSQRT_HD = 0.08838834764831845f;

constexpr size_t MiB = 1u << 20;
constexpr size_t WS_CTL = 0, CTL_ZERO_BYTES = 1 * MiB;
constexpr size_t WS_WIN = 1 * MiB;
constexpr size_t WS_WOUT = 29 * MiB;
constexpr size_t WS_WGU = 37 * MiB;
constexpr size_t WS_WDN = 81 * MiB;
constexpr size_t WS_HB = 104 * MiB;
constexpr size_t WS_PROJ = 168 * MiB;
constexpr size_t WS_MIX = 392 * MiB;
constexpr size_t WS_GATES = 456 * MiB;
constexpr size_t WS_LSE = 457 * MiB;
constexpr size_t WS_NCH = 459 * MiB;
constexpr size_t WS_NPREV = WS_NCH + 512 * 1024;
constexpr size_t WS_SC = 460 * MiB;
constexpr size_t WS_GS = 460 * MiB + 65536;
constexpr size_t WS_KC = 462 * MiB;
constexpr size_t WS_END = 494 * MiB;
constexpr size_t DO_ATT = 0, DO_CPT = 96 * MiB;
constexpr int CW_BAR = 4096;
constexpr int CW_ROWSS = 65536;
static_assert((CW_ROWSS + T) * 4 <= (int)CTL_ZERO_BYTES && CW_BAR + 16 * 3456 <= CW_ROWSS, "CTL words inside the memset region");

constexpr int RING_BYTES = 131072;
constexpr int SM_OFF = 135168;
constexpr int LDSCTL_OFF = 143360, MISC_OFF = LDSCTL_OFF + 320;
constexpr int LDS_BYTES = 147456;
static_assert(MISC_OFF + 128 <= LDS_BYTES, "LDS map");

#define GAS __attribute__((address_space(1)))
#define LAS __attribute__((address_space(3)))
typedef unsigned short bf16;
typedef unsigned v4u __attribute__((ext_vector_type(4)));
typedef unsigned v2u __attribute__((ext_vector_type(2)));
typedef float f32x4 __attribute__((ext_vector_type(4)));
typedef short bf16x8 __attribute__((ext_vector_type(8)));
typedef short s16x4 __attribute__((ext_vector_type(4)));
typedef GAS unsigned gu32;
#define RLX_AGENT __ATOMIC_RELAXED, __HIP_MEMORY_SCOPE_AGENT
#define LDS_WAIT() asm volatile("s_waitcnt lgkmcnt(0)" ::: "memory")
#define VM_WAIT() asm volatile("s_waitcnt vmcnt(0)" ::: "memory")
#define LBAR() do { asm volatile("s_waitcnt lgkmcnt(0)" ::: "memory"); __builtin_amdgcn_s_barrier(); asm volatile("" ::: "memory"); } while (0)
__device__ __forceinline__ unsigned pk2(float lo, float hi) { return pg8::cvt_pk_bf16(lo, hi); }
__device__ __forceinline__ float bf_lo(unsigned u) { return __uint_as_float(u << 16); }
__device__ __forceinline__ float bf_hi(unsigned u) { return __uint_as_float(u & 0xffff0000u); }
__device__ __forceinline__ void unpack8(const v4u r, float* f) { f[0] = bf_lo(r.x); f[1] = bf_hi(r.x); f[2] = bf_lo(r.y); f[3] = bf_hi(r.y); f[4] = bf_lo(r.z); f[5] = bf_hi(r.z); f[6] = bf_lo(r.w); f[7] = bf_hi(r.w); }
__device__ __forceinline__ v4u pack8(const float* f) { v4u r; r.x = pk2(f[0], f[1]); r.y = pk2(f[2], f[3]); r.z = pk2(f[4], f[5]); r.w = pk2(f[6], f[7]); return r; }
__device__ __forceinline__ f32x4 mfma16(bf16x8 a, bf16x8 b, f32x4 c) { return __builtin_amdgcn_mfma_f32_16x16x32_bf16(a, b, c, 0, 0, 0); }
__device__ __forceinline__ s16x4 tr_read(LAS unsigned char* p) { return __builtin_amdgcn_ds_read_tr16_b64_v4i16((LAS s16x4*)p); }
__device__ __forceinline__ bf16x8 cat44(s16x4 lo, s16x4 hi) { return __builtin_shufflevector(lo, hi, 0, 1, 2, 3, 4, 5, 6, 7); }
__device__ __forceinline__ float siluf(float y) { return y * __builtin_amdgcn_rcpf(1.0f + __expf(-y)); }
__device__ __forceinline__ float sigmf(float y) { return __builtin_amdgcn_rcpf(1.0f + __expf(-y)); }
__device__ __forceinline__ const bf16* seg_ptr(const bf16* proj, int seg, int h) { return proj + (size_t)(seg * NH + h) * T * HD; }
__device__ __forceinline__ int kimg(int r, int ch) { return r * 256 + ((ch ^ (r & 15)) << 4); }
__device__ __forceinline__ int vimg(int r, int ch) { return r * 256 + ((ch ^ ((r & 7) << 1)) << 4); }
#define XB_TMO      128
#define XB_XCNT(j)  (256  + 64 * (j))
#define XB_XSUB(j)  (1280 + 64 * (j))
#define XB_XGEN(j)  (2304 + 64 * (j))
#define XB_TOP      3328
#define XB_TOPGEN   3392
#define XCD_BAR_WORDS 3456
#define XB_SPIN_CAP (1u << 18)

__device__ __forceinline__ unsigned xb_ld(unsigned* p)              { return __hip_atomic_load(p, __ATOMIC_RELAXED, __HIP_MEMORY_SCOPE_AGENT); }
__device__ __forceinline__ unsigned xb_add(unsigned* p, unsigned v) { return __hip_atomic_fetch_add(p, v, __ATOMIC_RELAXED, __HIP_MEMORY_SCOPE_AGENT); }
__device__ __forceinline__ unsigned xb_xcc_id() { return (unsigned)__builtin_amdgcn_s_getreg((3 << 11) | 20) & 0xFu; }
#define XB_SPIN(cond, bar) do { unsigned _sp = 0; while (cond) { __builtin_amdgcn_s_sleep(1); \
    if ((++_sp & 255u) == 0u) { if (xb_ld(&(bar)[XB_TMO])) break; if (_sp > XB_SPIN_CAP) { atomicAdd(&(bar)[XB_TMO], 1u); break; } } } } while (0)

struct XcdBarrier {
    unsigned* bar; unsigned x;
    volatile LAS unsigned* st;
};

__device__ __forceinline__ XcdBarrier xcd_barrier_post(unsigned* bar, volatile LAS unsigned* st) {
    XcdBarrier b; b.bar = bar; b.x = xb_xcc_id(); b.st = st;
    if (threadIdx.x == 0) (void)xb_add(&bar[XB_XCNT(b.x)], 1u);
    return b;
}
__device__ __forceinline__ void xcd_barrier_complete(unsigned* bar, unsigned x, unsigned& nloc, unsigned& nx) {
    const unsigned G = gridDim.x * gridDim.y * gridDim.z;
    unsigned sum, cnt, mine, sp = 0u;
    for (;;) {
        sum = 0u; cnt = 0u; mine = 0u;
#pragma unroll
        for (unsigned j = 0; j < 16; ++j) { const unsigned c = xb_ld(&bar[XB_XCNT(j)]); sum += c; cnt += (c > 0u) ? 1u : 0u; mine = (j == x) ? c : mine; }
        if (sum == G) break;
        __builtin_amdgcn_s_sleep(1);
        if ((++sp & 255u) == 0u) { if (xb_ld(&bar[XB_TMO])) break; if (sp > XB_SPIN_CAP) { atomicAdd(&bar[XB_TMO], 1u); break; } }
    }
    nloc = mine > 0u ? mine : 1u; nx = cnt > 0u ? cnt : 1u;
}

__device__ __forceinline__ void xcd_barrier(const XcdBarrier& b) {
    asm volatile("s_waitcnt vmcnt(0)" ::: "memory");
    __syncthreads();
    if (threadIdx.x == 0) {
        unsigned* bar = b.bar;
        __builtin_amdgcn_s_waitcnt(0);
        unsigned nloc = b.st[0], nx = b.st[1];
        if (nloc == 0u) { xcd_barrier_complete(bar, b.x, nloc, nx); b.st[0] = nloc; b.st[1] = nx; }
        const unsigned old = xb_add(&bar[XB_XSUB(b.x)], 1u);
        const unsigned gen = old / nloc;
        if (old + 1u == (gen + 1u) * nloc) {
            __builtin_amdgcn_fence(__ATOMIC_RELEASE, "agent");
            asm volatile("s_waitcnt vmcnt(0)" ::: "memory");
            const unsigned og = xb_add(&bar[XB_TOP], 1u);
            const unsigned tg = og / nx;
            if (og + 1u == (tg + 1u) * nx) xb_add(&bar[XB_TOPGEN], 1u);
            else XB_SPIN(xb_ld(&bar[XB_TOPGEN]) == tg, bar);
            __builtin_amdgcn_fence(__ATOMIC_ACQUIRE, "agent");
            xb_add(&bar[XB_XGEN(b.x)], 1u);
            asm volatile("s_waitcnt vmcnt(0)" ::: "memory");
        } else {
            XB_SPIN(xb_ld(&bar[XB_XGEN(b.x)]) == gen, bar);
            __builtin_amdgcn_fence(__ATOMIC_ACQUIRE, "agent");
            asm volatile("s_waitcnt vmcnt(0)" ::: "memory");
        }
    }
    __syncthreads();
}

__device__ __forceinline__ float wave_sum(float v) {
#pragma unroll
    for (int o = 1; o < 64; o <<= 1) v += __shfl_xor(v, o);
    return v;
}
struct TItem { const float* W; const float* ksc; bf16* WT; int ldw, K, mode, k0, n0; };
__device__ __forceinline__ void p0_load(const TItem& t, f32x4 (&v)[8], int lane) {
    const float* p = t.W + (size_t)(t.k0 + (lane >> 3)) * t.ldw + t.n0 + 4 * (lane & 7);
#pragma unroll
    for (int i = 0; i < 8; ++i) v[i] = __builtin_nontemporal_load((const f32x4*)(p + (size_t)(8 * i) * t.ldw));
}
__device__ __forceinline__ void p0_emit(const TItem& t, const f32x4 (&v)[8], LAS float* scr, int lane) {
#pragma unroll
    for (int i = 0; i < 8; ++i) { const int kk = 8 * i + (lane >> 3); f32x4 y = v[i]; if (t.ksc) y = y * t.ksc[t.k0 + kk];
        LAS float* d = scr + kk * 33 + 4 * (lane & 7); d[0] = y.x; d[1] = y.y; d[2] = y.z; d[3] = y.w; }
    LDS_WAIT(); asm volatile("" ::: "memory");
    const int c = lane & 7;
    int nbase = t.n0; if (t.mode) nbase = ((t.n0 >> 7) << 8) + (t.n0 & 127) + (t.mode == 2 ? 128 : 0);
#pragma unroll
    for (int j = 0; j < 4; ++j) { const int n = (lane >> 3) + 8 * j; const LAS float* s = scr + (8 * c) * 33 + n;
        v4u o; o.x = pk2(s[0 * 33], s[1 * 33]); o.y = pk2(s[2 * 33], s[3 * 33]); o.z = pk2(s[4 * 33], s[5 * 33]); o.w = pk2(s[6 * 33], s[7 * 33]);
        *(GAS v4u*)(t.WT + (size_t)(nbase + n) * t.K + t.k0 + 8 * c) = o; }
    LDS_WAIT(); asm volatile("" ::: "memory");
}
constexpr int P0_SCR = 8448, P0_WG = 69632;
__device__ __forceinline__ int wgimg(int gate, int c) { return P0_WG + gate * 4096 + ((c ^ gate) << 4); }
template <int PARTS> __device__ __forceinline__ void p0_prologue(LAS unsigned char* lds, LAS float* sm, const float* const* in, unsigned char* ws, int vcu, int G, int tid, int lane, int wave) {
    const float* w_in = in[2]; const float* w_out = in[9]; const float* nfg = in[10]; const float* w_gate = in[11]; const float* w_up = in[12]; const float* w_down = in[13];
    {   float f[8][8];
#pragma unroll
        for (int i = 0; i < 8; ++i) { const int pr = tid + i * NWAVES * 64, gate = pr & 15, c = pr >> 4;
#pragma unroll
            for (int j = 0; j < 8; ++j) f[i][j] = w_in[(size_t)(8 * c + j) * INW + PJ + gate]; }
#pragma unroll
        for (int i = 0; i < 8; ++i) { const int pr = tid + i * NWAVES * 64, gate = pr & 15, c = pr >> 4; *(LAS v4u*)(lds + wgimg(gate, c)) = pack8(f[i]); }
    }
    LAS float* scr = (LAS float*)(lds + wave * P0_SCR);
    const int gw = vcu * NWAVES + wave, NGW = G * NWAVES;
    bf16* WIN = (bf16*)(ws + WS_WIN); bf16* WOUT = (bf16*)(ws + WS_WOUT); bf16* WGU = (bf16*)(ws + WS_WGU); bf16* WDN = (bf16*)(ws + WS_WDN);
    constexpr int I_IN = (DM / 64) * (PJ / 32), I_OUT = (DM / 64) * (DM / 32), I_G = (DM / 64) * (FF / 32), I_D = (FF / 64) * (DM / 32);
    constexpr int NITEMS = I_IN + I_OUT + 2 * I_G + I_D;
    auto decode = [&](int it) -> TItem {
        TItem t; int r = it, nblk;
        if (r < I_IN) { t.W = w_in; t.ldw = INW; nblk = PJ / 32; t.K = DM; t.WT = WIN; t.ksc = nullptr; t.mode = 0; }
        else if ((r -= I_IN) < I_OUT) { t.W = w_out; t.ldw = DM; nblk = DM / 32; t.K = DM; t.WT = WOUT; t.ksc = nullptr; t.mode = 0; }
        else if ((r -= I_OUT) < I_G) { t.W = w_gate; t.ldw = FF; nblk = FF / 32; t.K = DM; t.WT = WGU; t.ksc = nfg; t.mode = 1; }
        else if ((r -= I_G) < I_G) { t.W = w_up; t.ldw = FF; nblk = FF / 32; t.K = DM; t.WT = WGU; t.ksc = nfg; t.mode = 2; }
        else { r -= I_G; t.W = w_down; t.ldw = DM; nblk = DM / 32; t.K = FF; t.WT = WDN; t.ksc = nullptr; t.mode = 0; }
        const int kb = r / nblk; t.k0 = 64 * kb; t.n0 = 32 * (r - kb * nblk); return t; };
    if (PARTS & 1) {
        int it = gw; f32x4 va[8], vb[8]; TItem ta, tb;
        if (it < NITEMS) { ta = decode(it); p0_load(ta, va, lane); }
        while (it < NITEMS) {
            int itn = it + NGW; if (itn < NITEMS) { tb = decode(itn); p0_load(tb, vb, lane); }
            p0_emit(ta, va, scr, lane);
            it = itn; if (it >= NITEMS) break;
            itn = it + NGW; if (itn < NITEMS) { ta = decode(itn); p0_load(ta, va, lane); }
            p0_emit(tb, vb, scr, lane);
            it = itn;
        }
    }
    const float* x = in[0]; const float* nmg = in[1]; const float* gate_b = in[5];
    bf16* HB = (bf16*)(ws + WS_HB); float* GATES = (float*)(ws + WS_GATES);
    f32x4 gn[8];
#pragma unroll
    for (int j = 0; j < 8; ++j) gn[j] = *((const f32x4*)nmg + lane + 64 * j);
    if (PARTS & 2) for (int rg = vcu; rg < T / 64; rg += G) {
        const int m0 = rg * 64 + 8 * wave;
        f32x4 nv[8];
        { const GAS f32x4* xr = (const GAS f32x4*)(x + (size_t)m0 * DM) + lane;
#pragma unroll
          for (int j = 0; j < 8; ++j) nv[j] = __builtin_nontemporal_load(xr + 64 * j); }
#pragma unroll 1
        for (int i = 0; i < 8; ++i) {
            f32x4 v[8]; float s = 0.f;
#pragma unroll
            for (int j = 0; j < 8; ++j) { v[j] = nv[j]; s += (v[j].x * v[j].x + v[j].y * v[j].y) + (v[j].z * v[j].z + v[j].w * v[j].w); }
            if (i < 7) { const GAS f32x4* xr = (const GAS f32x4*)(x + (size_t)(m0 + i + 1) * DM) + lane;
#pragma unroll
                for (int j = 0; j < 8; ++j) nv[j] = __builtin_nontemporal_load(xr + 64 * j); }
            const float rstd = 1.0f / sqrtf(wave_sum(s) * (1.f / DM) + EPS);
            GAS unsigned long long* o8 = (GAS unsigned long long*)(HB + (size_t)(m0 + i) * DM) + lane;
#pragma unroll
            for (int j = 0; j < 8; ++j) { const f32x4 y = v[j] * rstd * gn[j]; o8[64 * j] = (unsigned long long)pk2(y.x, y.y) | ((unsigned long long)pk2(y.z, y.w) << 32); }
        }
        VM_WAIT(); __syncthreads();
        {
            const int x16 = lane & 15, g = lane >> 4, q = wave >> 1, kh = wave & 1;
            const bf16* hp = HB + (size_t)(rg * 64 + 16 * q + x16) * DM + 1024 * kh + 8 * g;
            f32x4 acc = (f32x4){0.f, 0.f, 0.f, 0.f};
#pragma unroll 8
            for (int s = 0; s < 32; ++s) {
                const bf16x8 bq = __builtin_bit_cast(bf16x8, *(const v4u*)(hp + 32 * s));
                const bf16x8 a = *(const LAS bf16x8*)(lds + wgimg(x16, 128 * kh + 4 * s + g));
                acc = mfma16(a, bq, acc);
            }
            if (kh) *(LAS f32x4*)(sm + (q * 64 + lane) * 4) = acc;
            __syncthreads();
            if (!kh) { const f32x4 o = *(const LAS f32x4*)(sm + (q * 64 + lane) * 4); const f32x4 gb = *(const f32x4*)(gate_b + 4 * g);
                *(f32x4*)(GATES + (size_t)(rg * 64 + 16 * q + x16) * 16 + 4 * g) = acc + o + gb; }
            __syncthreads();
        }
    }
}

struct AttnP { int b, h, dil, gi, r, n; };
__device__ __forceinline__ AttnP attn_decode(int L) {
    const int xc = (L & 255) >> 5, jj = L & 31, ii = L >> 8, qx = jj + 32 * ii;
    const int bh = 4 * xc + qx / 96, rem = qx % 96, gi = rem >> 5, i32 = rem & 31, sh = 2 * gi;
    AttnP p; p.gi = gi; p.dil = 1 << sh; p.b = bh >> 3; p.h = bh & 7; p.r = i32 & (p.dil - 1); p.n = i32 >> sh; return p;
}
__device__ __forceinline__ void attn_prefetch_k(const bf16* proj, const AttnP& p, int tid, v4u (&kr)[8]) {
    const unsigned vo = (unsigned)((tid >> 4) * p.dil * HD + (tid & 15) * 8) * 2u;
#pragma unroll
    for (int it = 0; it < 8; ++it) {
        const int ci = 128 * (p.n - 1) + it * 32 + ((p.n == 0 && it < 4) ? 128 : 0);
        const char* sb = (const char*)(seg_ptr(proj, S_AK, p.h) + ((size_t)p.b * SEQ + (size_t)ci * p.dil + p.r) * HD);
        kr[it] = *(const v4u*)(sb + vo);
    }
}
__device__ __forceinline__ void attn_load_q(const bf16* proj, const AttnP& p, int lane, int w, v4u (&qr)[4]) {
    const char* qb = (const char*)(seg_ptr(proj, S_AQ, p.h) + ((size_t)p.b * SEQ + (size_t)(128 * p.n + 16 * w) * p.dil + p.r) * HD);
    const unsigned qo = (unsigned)((lane & 15) * p.dil * HD + 8 * (lane >> 4)) * 2u;
#pragma unroll
    for (int s = 0; s < 4; ++s) qr[s] = *(const v4u*)(qb + qo + 64 * s);
}
__device__ __forceinline__ void attn_prefetch_v(const bf16* proj, const AttnP& p, int tid, v4u (&vr)[8]) {
    const unsigned vo = (unsigned)((tid >> 4) * p.dil * HD + (tid & 15) * 8) * 2u;
#pragma unroll
    for (int it = 0; it < 8; ++it) {
        const int ci = 128 * (p.n - 1) + it * 32 + ((p.n == 0 && it < 4) ? 128 : 0);
        const char* sb = (const char*)(seg_ptr(proj, S_AV, p.h) + ((size_t)p.b * SEQ + (size_t)ci * p.dil + p.r) * HD);
        vr[it] = *(const v4u*)(sb + vo);
    }
}
__device__ __forceinline__ void attn_stage(LAS unsigned char* lds, const AttnP& p, int tid, const v4u (&kr)[8], const v4u (&vr)[8], const v4u (&qr)[4], bf16x8 (&qf)[4]) {
    const int ch = tid & 15;
#pragma unroll
    for (int it = 0; it < 8; ++it) {
        const int row = it * 32 + (tid >> 4); const bool ok = (128 * (p.n - 1) + row) >= 0;
        v4u ko = kr[it], vo = vr[it];
        if (!ok) { ko = (v4u){0u, 0u, 0u, 0u}; vo = (v4u){0u, 0u, 0u, 0u}; }
        *(LAS v4u*)(lds + kimg(row, ch)) = ko;
        *(LAS v4u*)(lds + 65536 + vimg(row, ch)) = vo;
    }
#pragma unroll
    for (int s = 0; s < 4; ++s) qf[s] = __builtin_bit_cast(bf16x8, qr[s]);
}
template <bool FIRST, int MODE = 0> __device__ __forceinline__ void attn_compute(LAS unsigned char* lds, const AttnP& p, const bf16x8 (&qf)[4], float cb, bf16* og, float* osum, int lane, int w) {
    const int x = lane & 15, g = lane >> 4, n = p.n, q4 = x >> 2, p2 = x & 3;
    const size_t tq = (size_t)p.b * SEQ + (size_t)(128 * n + 16 * w + x) * p.dil + p.r;
    const int start = w < 6 ? w : 6;
    int kbase[4], vbase[8];
#pragma unroll
    for (int s = 0; s < 4; ++s) kbase[s] = (start * 16 + x) * 256 + (((4 * s + g) ^ x) << 4);
#pragma unroll
    for (int eb = 0; eb < 8; ++eb) vbase[eb] = 65536 + (start * 16 + 4 * g + q4) * 256 + (((2 * eb + (p2 >> 1)) ^ (((4 * g + q4) & 7) << 1)) << 4) + 8 * (p2 & 1);
    f32x4 oacc[8];
#pragma unroll
    for (int eb = 0; eb < 8; ++eb) oacc[eb] = (f32x4){0.f, 0.f, 0.f, 0.f};
    const int qrel = 16 * w + x; float sum = 0.f;
    bf16x8 ka[2][4];
#pragma unroll
    for (int h2 = 0; h2 < 2; ++h2)
#pragma unroll
        for (int s = 0; s < 4; ++s) ka[h2][s] = *(const LAS bf16x8*)(lds + kbase[s] + h2 * 4096);
#pragma unroll
    for (int i = 0; i < 5; ++i) {
        s16x4 va[8][2];
#pragma unroll
        for (int eb = 0; eb < 8; ++eb) { va[eb][0] = tr_read(lds + vbase[eb] + i * 8192); va[eb][1] = tr_read(lds + vbase[eb] + i * 8192 + 4096); }
        f32x4 sc[2];
#pragma unroll
        for (int h2 = 0; h2 < 2; ++h2) { sc[h2] = (f32x4){0.f, 0.f, 0.f, 0.f};
#pragma unroll
            for (int s = 0; s < 4; ++s) sc[h2] = mfma16(ka[h2][s], qf[s], sc[h2]); }
        if (i < 4) {
#pragma unroll
            for (int h2 = 0; h2 < 2; ++h2)
#pragma unroll
                for (int s = 0; s < 4; ++s) ka[h2][s] = *(const LAS bf16x8*)(lds + kbase[s] + (2 * i + 2 + h2) * 4096);
        }
        float pe[2][4];
#pragma unroll
        for (int h2 = 0; h2 < 2; ++h2)
#pragma unroll
            for (int q = 0; q < 4; ++q) {
                float e = __builtin_amdgcn_exp2f(sc[h2][q] - cb);
                if (FIRST || i == 0 || i == 4) { const int kr = (start + 2 * i + h2) * 16 + 4 * g + q - 128, dist = qrel - kr; const bool valid = (dist >= 0) && (dist <= 128) && (!FIRST || kr >= 0); e = valid ? e : 0.f; }
                pe[h2][q] = e; sum += e; }
        v4u pw; pw.x = pk2(pe[0][0], pe[0][1]); pw.y = pk2(pe[0][2], pe[0][3]); pw.z = pk2(pe[1][0], pe[1][1]); pw.w = pk2(pe[1][2], pe[1][3]);
        const bf16x8 pf = __builtin_bit_cast(bf16x8, pw);
#pragma unroll
        for (int eb = 0; eb < 8; ++eb) oacc[eb] = mfma16(cat44(va[eb][0], va[eb][1]), pf, oacc[eb]);
    }
    sum += __shfl_xor(sum, 16); sum += __shfl_xor(sum, 32);
    const float inv = 1.0f / sum;
    bf16* op = og + ((size_t)(p.gi * NH + p.h) * T + tq) * HD + 4 * g;
#pragma unroll
    for (int eb = 0; eb < 8; ++eb) { v2u o; o.x = pk2(oacc[eb][0] * inv, oacc[eb][1] * inv); o.y = pk2(oacc[eb][2] * inv, oacc[eb][3] * inv); if (MODE == 0) *(v2u*)(op + 16 * eb) = o; else asm volatile("" :: "v"(o.x), "v"(o.y)); }
    if (MODE == 0) { if (g == 0) osum[(size_t)(p.gi * NH + p.h) * T + tq] = sum; }
}
template <int MODE = 0> __device__ __forceinline__ void attn_phase(LAS unsigned char* lds, const bf16* proj, bf16* og, float* osum, const float* __restrict__ qg, const float* __restrict__ kg, int vcu, int G, int tid, int lane, int w) {
    int L = vcu; if (L >= 3072) return;
    float cb;
    { float mq = fmaxf(fabsf(qg[lane]), fabsf(qg[lane + 64])), mk = fmaxf(fabsf(kg[lane]), fabsf(kg[lane + 64]));
#pragma unroll
      for (int o = 32; o >= 1; o >>= 1) { mq = fmaxf(mq, __shfl_xor(mq, o)); mk = fmaxf(mk, __shfl_xor(mk, o)); }
      cb = 11.313708499f * mq * mk * LOG2E; }
    AttnP p = attn_decode(L);
    v4u kr[8], vr[8], qr[4];
    attn_prefetch_k(proj, p, tid, kr); attn_prefetch_v(proj, p, tid, vr); attn_load_q(proj, p, lane, w, qr);
    for (;;) {
        bf16x8 qf[4];
        attn_stage(lds, p, tid, kr, vr, qr, qf);
        LBAR();
        const int Ln = L + G; const bool more = Ln < 3072;
        const AttnP pn = attn_decode(more ? Ln : L);
        if (MODE != 2) { attn_prefetch_k(proj, pn, tid, kr); attn_prefetch_v(proj, pn, tid, vr); attn_load_q(proj, pn, lane, w, qr); }
        if (MODE != 1) { if (p.n == 0) attn_compute<true, MODE>(lds, p, qf, cb, og, osum, lane, w); else attn_compute<false, MODE>(lds, p, qf, cb, og, osum, lane, w); }
        LBAR();
        if (!more) break;
        p = pn; L = Ln;
    }
}

__device__ __forceinline__ void gate_prepass(const float* gates, float* gs, float* sc, int idx, int lane) {
    const int c = idx & 31, bh = idx >> 5, h = bh & 7, b = bh >> 3;
    const size_t t0 = (size_t)b * SEQ + 128 * c;
    const float* g0 = gates + (t0 + lane) * 16, * g1 = gates + (t0 + 64 + lane) * 16;
    const float i0 = g0[h], f0 = g0[8 + h], i1 = g1[h], f1 = g1[8 + h];
    float v0 = fminf(f0, 0.f) - log1pf(expf(-fabsf(f0))), v1 = fminf(f1, 0.f) - log1pf(expf(-fabsf(f1)));
#pragma unroll
    for (int o = 1; o < 64; o <<= 1) { const float a0 = __shfl_up(v0, o), a1 = __shfl_up(v1, o); if (lane >= o) { v0 += a0; v1 += a1; } }
    v1 += __shfl(v0, 63);
    const float u0 = i0 - v0, u1 = i1 - v1;
    float m = fmaxf(u0, u1);
#pragma unroll
    for (int o = 32; o >= 1; o >>= 1) m = fmaxf(m, __shfl_xor(m, o));
    float* gp = gs + (size_t)idx * 256;
    gp[lane] = v0; gp[64 + lane] = v1; gp[128 + lane] = u0; gp[192 + lane] = u1;
    if (lane == 63) { sc[idx] = v1; sc[1024 + idx] = v1 + m; sc[3072 + idx] = m; }
}
__device__ __forceinline__ void load_conv_w(const float* __restrict__ convw, const float* __restrict__ convb, int cc, float (&cw)[4][8], float (&cb)[8]) {
#pragma unroll
    for (int tap = 0; tap < 4; ++tap) { const f32x4 a = *(const f32x4*)(convw + tap * 2048 + cc), c = *(const f32x4*)(convw + tap * 2048 + cc + 4);
        cw[tap][0] = a.x; cw[tap][1] = a.y; cw[tap][2] = a.z; cw[tap][3] = a.w; cw[tap][4] = c.x; cw[tap][5] = c.y; cw[tap][6] = c.z; cw[tap][7] = c.w; }
    const f32x4 a = *(const f32x4*)(convb + cc), c = *(const f32x4*)(convb + cc + 4);
    cb[0] = a.x; cb[1] = a.y; cb[2] = a.z; cb[3] = a.w; cb[4] = c.x; cb[5] = c.y; cb[6] = c.z; cb[7] = c.w;
}
__device__ __forceinline__ void stage_conv_w(LAS float* sm, const float* __restrict__ convw, const float* __restrict__ convb, int h, int tid) {
    for (int i = tid; i < 1280; i += NWAVES * 64) { const int path = i / 640, r = i - path * 640, tap = r >> 7, d = r & 127, cc = (path == 0 ? 1024 : 0) + h * 128 + d;
        sm[i] = tap < 4 ? convw[tap * 2048 + cc] : convb[cc]; }
}
__device__ __forceinline__ void load_conv_w_lds(const LAS float* sm, int path, int ch, float (&cw)[4][8], float (&cb)[8]) {
#pragma unroll
    for (int tap = 0; tap < 4; ++tap) { const f32x4 a = *(const LAS f32x4*)(sm + path * 640 + tap * 128 + ch * 8), c = *(const LAS f32x4*)(sm + path * 640 + tap * 128 + ch * 8 + 4);
        cw[tap][0] = a.x; cw[tap][1] = a.y; cw[tap][2] = a.z; cw[tap][3] = a.w; cw[tap][4] = c.x; cw[tap][5] = c.y; cw[tap][6] = c.z; cw[tap][7] = c.w; }
    const f32x4 a = *(const LAS f32x4*)(sm + path * 640 + 512 + ch * 8), c = *(const LAS f32x4*)(sm + path * 640 + 512 + ch * 8 + 4);
    cb[0] = a.x; cb[1] = a.y; cb[2] = a.z; cb[3] = a.w; cb[4] = c.x; cb[5] = c.y; cb[6] = c.z; cb[7] = c.w;
}
__device__ __forceinline__ void conv4x8(const v4u (&raw)[7], const float (&cw)[4][8], const float (&cb)[8], float (&y)[4][8]) {
#pragma unroll
    for (int i = 0; i < 4; ++i)
#pragma unroll
        for (int j = 0; j < 8; ++j) y[i][j] = cb[j];
#pragma unroll
    for (int r = 0; r < 7; ++r) { float f[8]; unpack8(raw[r], f);
#pragma unroll
        for (int i = 0; i < 4; ++i) { const int tap = r - i; if (tap >= 0 && tap < 4) {
#pragma unroll
            for (int j = 0; j < 8; ++j) y[i][j] += f[j] * cw[tap][j]; } } }
#pragma unroll
    for (int i = 0; i < 4; ++i)
#pragma unroll
        for (int j = 0; j < 8; ++j) y[i][j] = siluf(y[i][j]);
}

struct MARegs { v4u kraw[7], qraw[7], vr[4]; f32x4 u4; float umax; };
__device__ __forceinline__ void mA_prefetch(const bf16* proj, const float* gs, const float* sc, int idx, int tid, MARegs& R) {
    const int c = idx & 31, bh = idx >> 5, h = bh & 7, b = bh >> 3, rg = tid >> 4, ch = tid & 15;
    const size_t t0 = (size_t)b * SEQ + 128 * c;
    const bf16* bk3 = seg_ptr(proj, S_MK, h) + (t0 - 3) * HD, * bq3 = seg_ptr(proj, S_MQ, h) + (t0 - 3) * HD, * bv = seg_ptr(proj, S_MV, h) + t0 * HD;
    const int lo = (c == 0) ? 3 : 0;
#pragma unroll
    for (int j = 0; j < 7; ++j) { int row3 = 4 * rg + j; row3 = row3 < lo ? lo : row3;
        const unsigned vo = (unsigned)(row3 * HD + ch * 8) * 2u;
        R.kraw[j] = *(const v4u*)((const char*)bk3 + vo); R.qraw[j] = *(const v4u*)((const char*)bq3 + vo); }
    const unsigned vo = (unsigned)(4 * rg * HD + ch * 8) * 2u;
#pragma unroll
    for (int i = 0; i < 4; ++i) R.vr[i] = *(const v4u*)((const char*)(bv + i * HD) + vo);
    R.u4 = *(const f32x4*)(gs + (size_t)idx * 256 + 128 + 4 * rg);
    R.umax = __hip_atomic_load(sc + 3072 + idx, __ATOMIC_RELAXED, __HIP_MEMORY_SCOPE_AGENT);
}
__device__ __forceinline__ void mlstmA_phase(LAS unsigned char* lds, LAS float* sm, const bf16* proj, const float* gates, const float* __restrict__ convw, const float* __restrict__ convb,
                                             bf16* kvt, float* nch, float* sc, float* gs, bf16* kc, bf16* mix, int vcu, int G, int tid, int lane, int w) {
    if (vcu >= 1024) return;
    for (int idx = vcu + G * w; idx < 1024; idx += G * NWAVES) gate_prepass(gates, gs, sc, idx, lane);
    int hcur = (vcu >> 5) & 7; stage_conv_w(sm, convw, convb, hcur, tid);
    VM_WAIT(); __syncthreads();
    int idx = vcu;
    MARegs R; mA_prefetch(proj, gs, sc, idx, tid, R);
    const int x = lane & 15, g = lane >> 4, rg = tid >> 4, ch = tid & 15;
    for (;;) {
        const int c = idx & 31, bh = idx >> 5, h = bh & 7, b = bh >> 3;
        const size_t t0 = (size_t)b * SEQ + 128 * c;
        if (h != hcur) { hcur = h; stage_conv_w(sm, convw, convb, hcur, tid); VM_WAIT(); LBAR(); }
        if (c == 0 && rg == 0) {
#pragma unroll
            for (int j = 0; j < 3; ++j) { R.kraw[j] = (v4u){0u, 0u, 0u, 0u}; R.qraw[j] = (v4u){0u, 0u, 0u, 0u}; } }
        {
            float cw[4][8], cb[8]; load_conv_w_lds(sm, 0, ch, cw, cb);
            float y[4][8]; conv4x8(R.kraw, cw, cb, y);
#pragma unroll
            for (int i = 0; i < 4; ++i) { const int l = 4 * rg + i; const float wa = __expf(R.u4[i] - R.umax);
#pragma unroll
                for (int j = 0; j < 8; ++j) y[i][j] *= RSQRT_HD;
                *(v4u*)(kc + ((size_t)h * T + t0 + l) * HD + ch * 8) = pack8(y[i]);
#pragma unroll
                for (int j = 0; j < 8; ++j) y[i][j] *= wa;
                *(LAS v4u*)(lds + vimg(l, ch)) = pack8(y[i]); }
        }
        {
            float cw[4][8], cb[8]; load_conv_w_lds(sm, 1, ch, cw, cb);
            float y[4][8]; conv4x8(R.qraw, cw, cb, y);
#pragma unroll
            for (int i = 0; i < 4; ++i) *(v4u*)(mix + (t0 + 4 * rg + i) * DM + AW + h * 128 + ch * 8) = pack8(y[i]);
        }
#pragma unroll
        for (int i = 0; i < 4; ++i) *(LAS v4u*)(lds + 32768 + vimg(4 * rg + i, ch)) = R.vr[i];
        LBAR();
        const int idn = idx + G; const bool more = idn < 1024;
        mA_prefetch(proj, gs, sc, more ? idn : idx, tid, R);
        f32x4 acc[8], accn = (f32x4){0.f, 0.f, 0.f, 0.f};
#pragma unroll
        for (int db = 0; db < 8; ++db) acc[db] = (f32x4){0.f, 0.f, 0.f, 0.f};
        const int q4 = x >> 2, p2 = x & 3;
        const int xr = ((4 * g + q4) & 7) << 1;
        const int rowb = (4 * g + q4) * 256 + 8 * (p2 & 1);
        int vbase = 32768 + rowb + (((2 * w + (p2 >> 1)) ^ xr) << 4), kb[8];
#pragma unroll
        for (int db = 0; db < 8; ++db) kb[db] = rowb + (((2 * db + (p2 >> 1)) ^ xr) << 4);
        const bf16x8 ones = (bf16x8){0x3F80, 0x3F80, 0x3F80, 0x3F80, 0x3F80, 0x3F80, 0x3F80, 0x3F80};
#pragma unroll
        for (int ks = 0; ks < 4; ++ks) {
            const bf16x8 vf = cat44(tr_read(lds + vbase + ks * 8192), tr_read(lds + vbase + ks * 8192 + 4096));
#pragma unroll
            for (int db = 0; db < 8; ++db) {
                const bf16x8 kf = cat44(tr_read(lds + kb[db] + ks * 8192), tr_read(lds + kb[db] + ks * 8192 + 4096));
                acc[db] = mfma16(kf, vf, acc[db]);
                if (db == w) accn = mfma16(kf, ones, accn);
            }
        }
        bf16* kp = kvt + (size_t)idx * 16384 + (size_t)(16 * w + x) * 128 + 4 * g;
#pragma unroll
        for (int db = 0; db < 8; ++db) { v2u o; o.x = pk2(acc[db][0], acc[db][1]); o.y = pk2(acc[db][2], acc[db][3]); *(v2u*)(kp + 16 * db) = o; }
        if (x == 0) *(f32x4*)(nch + (size_t)idx * 128 + 16 * w + 4 * g) = accn;
        LBAR();
        if (!more) break;
        idx = idn;
    }
}

__device__ __forceinline__ void p3_merge_task(const bf16* og, const float* lse, bf16* mix, int task) {
    const int t = task >> 7, rem = task & 127, h = rem >> 4, ch = rem & 15;
    float w0 = lse[(size_t)h * T + t], w1 = lse[(size_t)(NH + h) * T + t], w2 = lse[(size_t)(2 * NH + h) * T + t];
    const float inv = 1.0f / (w0 + w1 + w2); w0 *= inv; w1 *= inv; w2 *= inv;
    const size_t o = ((size_t)h * T + t) * HD + ch * 8;
    float a[8], bq[8], cq[8]; unpack8(__builtin_nontemporal_load((const v4u*)(og + o)), a); unpack8(__builtin_nontemporal_load((const v4u*)(og + (size_t)NH * T * HD + o)), bq); unpack8(__builtin_nontemporal_load((const v4u*)(og + (size_t)2 * NH * T * HD + o)), cq);
#pragma unroll
    for (int j = 0; j < 8; ++j) a[j] = a[j] * w0 + bq[j] * w1 + cq[j] * w2;
    *(v4u*)(mix + (size_t)t * DM + h * 128 + ch * 8) = pack8(a);
}
__device__ __forceinline__ void p3_scan_merge(const bf16* kvt, const float* nch, float* sc, bf16* cpt, float* nprev, const bf16* og, const float* lse, bf16* mix, int vcu, int G, int tid) {
    const int half = tid >> 8, ht = tid & 255;
    if (half == 0) {
        for (int task = vcu * 256 + ht; task < 32 * 2048; task += G * 256) {
            const int bh = task >> 11, f8 = task & 2047;
            float C[8]; float m = -1e30f;
#pragma unroll
            for (int j = 0; j < 8; ++j) C[j] = 0.f;
#pragma unroll 1
            for (int c0 = 0; c0 < 32; c0 += 8) {
                v4u kvr[8]; float bl[8], mc[8];
#pragma unroll
                for (int k = 0; k < 8; ++k) { const int idx = bh * 32 + c0 + k; kvr[k] = __builtin_nontemporal_load((const v4u*)(kvt + (size_t)idx * 16384 + 8 * f8)); bl[k] = sc[idx]; mc[k] = sc[1024 + idx]; }
#pragma unroll
                for (int k = 0; k < 8; ++k) { const int idx = bh * 32 + c0 + k;
                    *(v4u*)(cpt + (size_t)idx * 16384 + 8 * f8) = pack8(C);
                    if (f8 == 0) sc[2048 + idx] = m;
                    const float mn = fmaxf(bl[k] + m, mc[k]), decay = expf(bl[k] + m - mn), scale = expf(mc[k] - mn);
                    float kv[8]; unpack8(kvr[k], kv);
#pragma unroll
                    for (int j = 0; j < 8; ++j) C[j] = C[j] * decay + kv[j] * scale;
                    m = mn; }
            }
        }
        for (int task = vcu * 256 + ht; task < 32 * 32; task += G * 256) {
            const int bh = task >> 5, f4 = task & 31;
            f32x4 C = (f32x4){0.f, 0.f, 0.f, 0.f}; float m = -1e30f;
#pragma unroll 8
            for (int c = 0; c < 32; ++c) {
                const int idx = bh * 32 + c; const float bl = sc[idx], mc = sc[1024 + idx];
                *(f32x4*)(nprev + (size_t)idx * 128 + 4 * f4) = C;
                const float mn = fmaxf(bl + m, mc), decay = expf(bl + m - mn), scale = expf(mc - mn);
                const f32x4 kv = *(const f32x4*)(nch + (size_t)idx * 128 + 4 * f4);
                C = C * decay + kv * scale; m = mn;
            }
        }
    }
    constexpr int NMERGE = T * NH * 16, SLICE = 8192;
    for (int base = vcu * SLICE; base < NMERGE; base += G * SLICE) {
        if (half) { for (int j = 0; j < 20; ++j) p3_merge_task(og, lse, mix, base + ht + 256 * j); }
        else      { for (int j = 0; j < 12; ++j) p3_merge_task(og, lse, mix, base + 5120 + ht + 256 * j); }
    }
}

struct MCRegs { v4u kr[4], vr[4], qr[4], cr[4]; float u[4], bq, npv, mprev, umax; };
__device__ __forceinline__ void mC_prefetch(const bf16* proj, const float* gs, const bf16* kc, const bf16* mix, const bf16* cpt, const float* nprev, const float* sc, int idx, int tid, int lane, int w, MCRegs& R) {
    const int c = idx & 31, bh = idx >> 5, h = bh & 7, b = bh >> 3, rg = tid >> 4, ch = tid & 15;
    const size_t t0 = (size_t)b * SEQ + 128 * c;
    const unsigned vk = (unsigned)(rg * HD + ch * 8) * 2u, vq = (unsigned)(rg * DM + ch * 8) * 2u;
#pragma unroll
    for (int it = 0; it < 4; ++it) {
        R.kr[it] = __builtin_nontemporal_load((const v4u*)((const char*)(kc + ((size_t)h * T + t0 + 32 * it) * HD) + vk));
        R.vr[it] = __builtin_nontemporal_load((const v4u*)((const char*)(seg_ptr(proj, S_MV, h) + (t0 + 32 * it) * HD) + vk));
        R.qr[it] = __builtin_nontemporal_load((const v4u*)((const char*)(mix + (t0 + 32 * it) * DM + AW + h * 128) + vq));
        R.cr[it] = __builtin_nontemporal_load((const v4u*)((const char*)(cpt + (size_t)idx * 16384 + 32 * it * 128) + vk));
        R.u[it] = gs[(size_t)idx * 256 + 128 + 32 * it + rg];
    }
    R.bq = gs[(size_t)idx * 256 + 16 * w + (lane & 15)];
    R.npv = 0.f; if (tid < 128) R.npv = nprev[(size_t)idx * 128 + tid];
    R.mprev = __hip_atomic_load(sc + 2048 + idx, __ATOMIC_RELAXED, __HIP_MEMORY_SCOPE_AGENT);
    R.umax = __hip_atomic_load(sc + 3072 + idx, __ATOMIC_RELAXED, __HIP_MEMORY_SCOPE_AGENT);
}
template <int MODE = 0> __device__ __forceinline__ void mlstmC_phase(LAS unsigned char* lds, LAS float* sm, const bf16* proj, const float* gs, const bf16* kc, const bf16* cpt, const float* nprev, const float* sc,
                                             const float* __restrict__ ng, bf16* mix, int vcu, int G, int tid, int lane, int w) {
    int idx = vcu; if (idx >= 1024) return;
    int hcur = (vcu >> 5) & 7; if (tid < 128) sm[640 + tid] = ng[hcur * 128 + tid];
    MCRegs R; mC_prefetch(proj, gs, kc, mix, cpt, nprev, sc, idx, tid, lane, w, R);
    const int x = lane & 15, g = lane >> 4, rg = tid >> 4, ch = tid & 15;
    for (;;) {
        const int c = idx & 31, bh = idx >> 5, h = bh & 7, b = bh >> 3;
        const size_t t0 = (size_t)b * SEQ + 128 * c;
        if (h != hcur) { hcur = h; LBAR(); if (tid < 128) sm[640 + tid] = ng[hcur * 128 + tid]; }
        const float mprev = R.mprev, M = fmaxf(mprev, R.umax), cs = __expf(mprev - M), fl = __expf(-(R.bq + M));
#pragma unroll
        for (int it = 0; it < 4; ++it) {
            const int l = it * 32 + rg;
            const float cf = __expf(R.u[it] - M);
            float y[8]; unpack8(R.kr[it], y);
#pragma unroll
            for (int j = 0; j < 8; ++j) y[j] *= cf;
            *(LAS v4u*)(lds + kimg(l, ch)) = pack8(y);
            *(LAS v4u*)(lds + 32768 + vimg(l, ch)) = R.vr[it];
            *(LAS v4u*)(lds + 65536 + kimg(l, ch)) = R.cr[it];
            *(LAS v4u*)(lds + 98304 + kimg(l, ch)) = R.qr[it];
        }
        if (tid < 128) sm[512 + tid] = R.npv;
        LBAR();
        const int idn = idx + G; const bool more = idn < 1024;
        if (MODE != 2) mC_prefetch(proj, gs, kc, mix, cpt, nprev, sc, more ? idn : idx, tid, lane, w, R);
        if (MODE == 1) { LBAR(); if (!more) break; idx = idn; continue; }
        const int lq = 16 * w + x;
        v2u mor[8];
        const int q4 = x >> 2, p2 = x & 3;
        int rb[4];
#pragma unroll
        for (int s = 0; s < 4; ++s) rb[s] = x * 256 + (((4 * s + g) ^ x) << 4);
        bf16x8 qf[4]; float qn = 0.f;
#pragma unroll
        for (int s = 0; s < 4; ++s) {
            qf[s] = *(const LAS bf16x8*)(lds + 98304 + w * 4096 + rb[s]);
            float y[8]; unpack8(__builtin_bit_cast(v4u, qf[s]), y);
#pragma unroll
            for (int j = 0; j < 8; ++j) qn += y[j] * sm[512 + 32 * s + 8 * g + j];
        }
        qn += __shfl_xor(qn, 16); qn += __shfl_xor(qn, 32);
        f32x4 acc[8];
#pragma unroll
        for (int eb = 0; eb < 8; ++eb) acc[eb] = (f32x4){0.f, 0.f, 0.f, 0.f};
#pragma unroll
        for (int s = 0; s < 4; ++s)
#pragma unroll
            for (int hf = 0; hf < 2; ++hf) {
                bf16x8 ca[4];
#pragma unroll
                for (int e4 = 0; e4 < 4; ++e4) ca[e4] = *(const LAS bf16x8*)(lds + 65536 + (4 * hf + e4) * 4096 + rb[s]);
#pragma unroll
                for (int e4 = 0; e4 < 4; ++e4) acc[4 * hf + e4] = mfma16(ca[e4], qf[s], acc[4 * hf + e4]);
            }
#pragma unroll
        for (int eb = 0; eb < 8; ++eb) acc[eb] = acc[eb] * cs;
        const int xr = ((4 * g + q4) & 7) << 1;
        int vb[8];
#pragma unroll
        for (int eb = 0; eb < 8; ++eb) vb[eb] = 32768 + (4 * g + q4) * 256 + 8 * (p2 & 1) + (((2 * eb + (p2 >> 1)) ^ xr) << 4);
        float dsum = 0.f;
        {
            const bf16* mo = seg_ptr(proj, S_MO, h) + (t0 + lq) * HD + 4 * g;
#pragma unroll
            for (int eb = 0; eb < 8; ++eb) mor[eb] = *(const v2u*)(mo + 16 * eb); }
#pragma unroll 2
        for (int i = 0; i < 4; ++i) {
            f32x4 sc2[2];
#pragma unroll
            for (int h2 = 0; h2 < 2; ++h2) { bf16x8 ka[4];
#pragma unroll
                for (int s = 0; s < 4; ++s) ka[s] = *(const LAS bf16x8*)(lds + (2 * i + h2) * 4096 + rb[s]);
                sc2[h2] = (f32x4){0.f, 0.f, 0.f, 0.f};
#pragma unroll
                for (int s = 0; s < 4; ++s) sc2[h2] = mfma16(ka[s], qf[s], sc2[h2]); }
            float pe[2][4];
#pragma unroll
            for (int h2 = 0; h2 < 2; ++h2)
#pragma unroll
                for (int q = 0; q < 4; ++q) { const float v = (16 * (2 * i + h2) + 4 * g + q <= lq) ? sc2[h2][q] : 0.f; pe[h2][q] = v; dsum += v; }
            v4u pw; pw.x = pk2(pe[0][0], pe[0][1]); pw.y = pk2(pe[0][2], pe[0][3]); pw.z = pk2(pe[1][0], pe[1][1]); pw.w = pk2(pe[1][2], pe[1][3]);
            const bf16x8 pf = __builtin_bit_cast(bf16x8, pw);
#pragma unroll
            for (int hf = 0; hf < 2; ++hf) {
                s16x4 va[4][2];
#pragma unroll
                for (int e4 = 0; e4 < 4; ++e4) { va[e4][0] = tr_read(lds + vb[4 * hf + e4] + i * 8192); va[e4][1] = tr_read(lds + vb[4 * hf + e4] + i * 8192 + 4096); }
#pragma unroll
                for (int e4 = 0; e4 < 4; ++e4) acc[4 * hf + e4] = mfma16(cat44(va[e4][0], va[e4][1]), pf, acc[4 * hf + e4]);
            }
        }
        dsum += __shfl_xor(dsum, 16); dsum += __shfl_xor(dsum, 32);
        const float den = cs * qn + dsum, inv = 1.0f / fmaxf(fabsf(den), fl);
        float ss = 0.f;
#pragma unroll
        for (int eb = 0; eb < 8; ++eb) { acc[eb] = acc[eb] * inv; ss += (acc[eb][0] * acc[eb][0] + acc[eb][1] * acc[eb][1]) + (acc[eb][2] * acc[eb][2] + acc[eb][3] * acc[eb][3]); }
        ss += __shfl_xor(ss, 16); ss += __shfl_xor(ss, 32);
        const float rstd = __builtin_amdgcn_rsqf(ss * (1.f / HD) + EPS);
        bf16* op = mix + (t0 + lq) * DM + AW + h * 128 + 4 * g;
        const LAS float* ngp = sm + 640 + 4 * g;
#pragma unroll
        for (int eb = 0; eb < 8; ++eb) {
            const v2u mr = mor[eb]; const f32x4 gv = *(const LAS f32x4*)(ngp + 16 * eb);
            const float o0 = acc[eb][0] * rstd * gv.x * sigmf(bf_lo(mr.x)), o1 = acc[eb][1] * rstd * gv.y * sigmf(bf_hi(mr.x)), o2 = acc[eb][2] * rstd * gv.z * sigmf(bf_lo(mr.y)), o3 = acc[eb][3] * rstd * gv.w * sigmf(bf_hi(mr.y));
            v2u o; o.x = pk2(o0, o1); o.y = pk2(o2, o3); if (MODE == 0) *(v2u*)(op + 16 * eb) = o; else asm volatile("" :: "v"(o.x), "v"(o.y));
        }
        LBAR();
        if (!more) break;
        idx = idn;
    }
}

struct Args { const float* in[14]; float* out; unsigned char* ws; int ph_lo, ph_hi, li, pad; };
__global__ void __launch_bounds__(NWAVES * 64, 2) hyb_fwd(Args args) {
    extern __shared__ __attribute__((aligned(16))) unsigned char lds_raw[];
    LAS unsigned char* lds = (LAS unsigned char*)lds_raw;
    volatile LAS unsigned* MISC = (volatile LAS unsigned*)(lds + MISC_OFF);
    LAS float* sm = (LAS float*)(lds + SM_OFF);
    const int tid = threadIdx.x, lane = tid & 63, wave = __builtin_amdgcn_readfirstlane(tid >> 6);
    const int G = gridDim.x; const int bx = blockIdx.x; const int vcu = (G % 8 == 0) ? (bx % 8) * (G / 8) + bx / 8 : bx;
    unsigned char* ws = args.ws;
    gu32* ctl = (gu32*)(ws + WS_CTL);
    for (int u = tid; u < (LDS_BYTES - LDSCTL_OFF) / 4; u += NWAVES * 64) ((LAS unsigned*)(lds + LDSCTL_OFF))[u] = 0u;
    __syncthreads();
    const XcdBarrier bar = xcd_barrier_post((unsigned*)(ctl + CW_BAR) + args.li * XCD_BAR_WORDS, MISC + 8);
#define GRID_BAR() xcd_barrier(bar)
#ifdef PROBE_T
#define STAMP(k) do { if (bx == 0 && tid == 0) { MISC[16 + (k)] = (unsigned)wall_clock64(); MISC[32 + (k)] = (unsigned)clock64(); } } while (0)
#else
#define STAMP(k) do { } while (0)
#endif
    STAMP(0);
    const int lo = args.ph_lo, hi = args.ph_hi;
#ifndef PH_MASK
#define PH_MASK 0xffffff
#endif
#define IN(k) (((PH_MASK >> (k)) & 1) && lo <= (k) && (k) < hi)
#define BOTH(k) (IN(k) && IN((k) + 1))

    bf16* WIN = (bf16*)(ws + WS_WIN); bf16* WOUT = (bf16*)(ws + WS_WOUT); bf16* WGU = (bf16*)(ws + WS_WGU); bf16* WDN = (bf16*)(ws + WS_WDN);
    bf16* HB = (bf16*)(ws + WS_HB); bf16* KVT = (bf16*)(ws + WS_HB); bf16* PROJ = (bf16*)(ws + WS_PROJ); bf16* HID = (bf16*)(ws + WS_PROJ); bf16* MIX = (bf16*)(ws + WS_MIX);
    float* GATES = (float*)(ws + WS_GATES); float* LSE = (float*)(ws + WS_LSE); float* NCHK = (float*)(ws + WS_NCH); float* NPREV = (float*)(ws + WS_NPREV); float* SC = (float*)(ws + WS_SC);
    float* ROWSS = (float*)(ws + WS_CTL) + CW_ROWSS; bf16* KC = (bf16*)(ws + WS_KC); float* GS = (float*)(ws + WS_GS);
    bf16* OG = (bf16*)((unsigned char*)args.out + DO_ATT); bf16* CPT = (bf16*)((unsigned char*)args.out + DO_CPT);

    if (IN(0)) { p0_prologue<3>(lds, sm, args.in, ws, vcu, G, tid, lane, wave); if (BOTH(0)) GRID_BAR(); STAMP(1); }
#ifdef PROBE_P0
    if (IN(8)) p0_prologue<1>(lds, sm, args.in, ws, vcu, G, tid, lane, wave);
    if (IN(9)) p0_prologue<2>(lds, sm, args.in, ws, vcu, G, tid, lane, wave);
#endif

    if (IN(1)) {
        pg8::Gemm g{HB, WIN, T, PJ, DM}; pg8::StaticOrder S; S.init(T, PJ, G, bx);
        pg8::EpiProj E{PROJ, T, args.in[6], args.in[7], sm, EPS, RSQRT_HD * LOG2E};
        pg8::gemm_phase<pg8::EpiProj, pg8::StaticOrder, true, true>(lds, g, S, E);
        if (BOTH(1)) GRID_BAR(); STAMP(2);
    }

    if (IN(2)) {
        attn_phase<0>(lds, PROJ, OG, LSE, args.in[6], args.in[7], vcu, G, tid, lane, wave); STAMP(9);
        mlstmA_phase(lds, sm, PROJ, GATES, args.in[3], args.in[4], KVT, NCHK, SC, GS, KC, MIX, vcu, G, tid, lane, wave);
        if (BOTH(2)) GRID_BAR(); STAMP(3);
    }

#ifdef PROBE_P2
    if (IN(10)) attn_phase<0>(lds, PROJ, OG, LSE, args.in[6], args.in[7], vcu, G, tid, lane, wave);
    if (IN(12)) attn_phase<1>(lds, PROJ, OG, LSE, args.in[6], args.in[7], vcu, G, tid, lane, wave);
    if (IN(13)) attn_phase<2>(lds, PROJ, OG, LSE, args.in[6], args.in[7], vcu, G, tid, lane, wave);
    if (IN(11)) mlstmA_phase(lds, sm, PROJ, GATES, args.in[3], args.in[4], KVT, NCHK, SC, GS, KC, MIX, vcu, G, tid, lane, wave);
#endif
    if (IN(3)) { p3_scan_merge(KVT, NCHK, SC, CPT, NPREV, OG, LSE, MIX, vcu, G, tid); if (BOTH(3)) GRID_BAR(); STAMP(4); }

    if (IN(4)) {
        mlstmC_phase<0>(lds, sm, PROJ, GS, KC, CPT, NPREV, SC, args.in[8], MIX, vcu, G, tid, lane, wave);
        if (BOTH(4)) GRID_BAR(); STAMP(5);
    }

#ifdef PROBE_P4
    if (IN(15)) mlstmC_phase<1>(lds, sm, PROJ, GS, KC, CPT, NPREV, SC, args.in[8], MIX, vcu, G, tid, lane, wave);
    if (IN(16)) mlstmC_phase<2>(lds, sm, PROJ, GS, KC, CPT, NPREV, SC, args.in[8], MIX, vcu, G, tid, lane, wave);
#endif
    if (IN(5)) {
        pg8::Gemm g{MIX, WOUT, T, DM, DM}; pg8::StaticOrder S; S.init(T, DM, G, bx);
        pg8::EpiRes1 E{args.in[0], args.out, HB, ROWSS, DM};
        pg8::gemm_phase<pg8::EpiRes1, pg8::StaticOrder, false, true>(lds, g, S, E);
        if (BOTH(5)) GRID_BAR(); STAMP(6);
    }

#ifdef PROBE_SLEEP
    { const long long until = wall_clock64() + 10000; while (wall_clock64() < until) __builtin_amdgcn_s_sleep(32); }
#endif
    if (IN(6)) {
        pg8::Gemm g{HB, WGU, T, 2 * FF, DM}; pg8::StaticOrder S; S.init(T, 2 * FF, G, bx);
        pg8::EpiSwi E{HID, FF, ROWSS, EPS};
        pg8::gemm_phase<pg8::EpiSwi, pg8::StaticOrder, false, true>(lds, g, S, E);
        if (BOTH(6)) GRID_BAR(); STAMP(7);
    }

#ifdef PROBE_G
    if (IN(17)) { pg8::Gemm g{PROJ, PROJ + (size_t)T * DM, T, 2 * FF, DM}; pg8::StaticOrder S; S.init(T, 2 * FF, G, bx); pg8::EpiNone E{}; pg8::gemm_phase<pg8::EpiNone, pg8::StaticOrder, true, true>(lds, g, S, E); }
    if (IN(14)) { pg8::Gemm g{HB, WGU, T, 2 * FF, DM}; pg8::StaticOrder S; S.init(T, 2 * FF, G, bx); pg8::EpiNone E{}; pg8::gemm_phase<pg8::EpiNone, pg8::StaticOrder, true, true>(lds, g, S, E); }
#endif
    if (IN(7)) {
        pg8::Gemm g{HID, WDN, T, DM, FF}; pg8::StaticOrder S; S.init(T, DM, G, bx);
        pg8::EpiRes2 E{args.out, DM};
        pg8::gemm_phase<pg8::EpiRes2, pg8::StaticOrder, false, true>(lds, g, S, E);
    }
    STAMP(8);
#ifdef PROBE_T
    if (bx == 0 && tid == 0) {
#if defined(PROBE_CLK)
        const unsigned dt = (MISC[32 + PROBE_TB] - MISC[32 + PROBE_TA]) / 200;
#elif defined(PROBE_TA)
        const unsigned dt = MISC[16 + PROBE_TB] - MISC[16 + PROBE_TA];
#else
        const unsigned dt = MISC[16 + PROBE_T + 1] - MISC[16 + PROBE_T];
#endif
        const long long until = wall_clock64() + (long long)dt * 10;
        while (wall_clock64() < until) __builtin_amdgcn_s_sleep(8); }
#endif
#undef IN
#undef BOTH
}

extern "C" void kernel_launch(void* const* d_in, const int* in_sizes, int n_in, void* d_out, int out_size, void* d_ws, size_t ws_size, hipStream_t stream) {
    static int grid = 0;
    if (grid == 0) {
        if (n_in != 14 || in_sizes[0] != T * DM || out_size != T * DM || ws_size < WS_END) { fprintf(stderr, "kernel_launch: unexpected shapes (n_in %d, in0 %d, out %d, ws %zu); nothing launched\n", n_in, n_in > 0 ? in_sizes[0] : -1, out_size, ws_size); grid = -1; return; }
        int dev = 0, cus = 0, per_cu = 0;
        if (hipGetDevice(&dev) != hipSuccess || hipDeviceGetAttribute(&cus, hipDeviceAttributeMultiprocessorCount, dev) != hipSuccess) { fprintf(stderr, "kernel_launch: hipGetDevice / hipDeviceGetAttribute failed\n"); grid = -1; return; }
        if (hipFuncSetAttribute((const void*)hyb_fwd, hipFuncAttributeMaxDynamicSharedMemorySize, LDS_BYTES) != hipSuccess) { fprintf(stderr, "kernel_launch: hipFuncSetAttribute failed\n"); grid = -1; return; }
        if (hipOccupancyMaxActiveBlocksPerMultiprocessor(&per_cu, (const void*)hyb_fwd, NWAVES * 64, LDS_BYTES) != hipSuccess || per_cu < 1)
            fprintf(stderr, "kernel_launch: note: occupancy query reports %d workgroups per CU\n", per_cu);
        (void)hipGetLastError();
        grid = cus;
    }
    if (grid < 0) return;
    if (hipMemsetAsync((char*)d_ws + WS_CTL, 0, CTL_ZERO_BYTES, stream) != hipSuccess) { fprintf(stderr, "kernel_launch: hipMemsetAsync failed\n"); return; }
    Args a{};
    for (int i = 0; i < 14; ++i) a.in[i] = (const float*)d_in[i];
    a.out = (float*)d_out; a.ws = (unsigned char*)d_ws;
    static const int plist[] = PHASE_LIST;
    constexpr int NL = (int)(sizeof(plist) / sizeof(int)) / 2;
    static_assert(NL >= 1 && NL <= 16, "launch list");
    for (int li = 0; li < NL; ++li) {
        a.ph_lo = plist[2 * li]; a.ph_hi = plist[2 * li + 1]; a.li = li;
        hipLaunchKernelGGL(hyb_fwd, dim3(grid), dim3(NWAVES * 64), LDS_BYTES, stream, a);
        const hipError_t le = hipPeekAtLastError();
        if (le != hipSuccess) { fprintf(stderr, "kernel_launch: launch %d failed: %s\n", li, hipGetErrorName(le)); break; }
    }
}
```
